# Optimizing an MI355X kernel written in HIP

```python
import math
import jax, jax.numpy as jnp
from jax import lax
import numpy as np

D_MODEL = 4096
BATCH = 4
SEQ = 2048
DEPTH = 1

HEAD_DIM = 128
N_A_HEADS = 16
N_A_KV_HEADS = 4
N_A_GROUP = N_A_HEADS // N_A_KV_HEADS
B_PATTERNS = ((128, 1), (512, 4), (2048, 16))
N_B_GROUPS = len(B_PATTERNS)
N_B_HEADS_PER_GROUP = 4
N_B_HEADS = N_B_GROUPS * N_B_HEADS_PER_GROUP
N_BRANCHES = 2
Q_BLOCK = 128
GRID_W = 64
ROPE_THETA = 10000.0
AXIS_ROPE_DIM = HEAD_DIM // 2
REL_BUCKETS = 32
REL_MAX_DIST = 1024
D_FF = ((8 * D_MODEL + 3 * 256 - 1) // (3 * 256)) * 256
EPS = 1e-6
NEG_INF = -1e30

A_Q_W = N_A_HEADS * HEAD_DIM
A_KV_W = N_A_KV_HEADS * HEAD_DIM
B_W = N_B_HEADS * HEAD_DIM
B_OUT_W = N_B_HEADS_PER_GROUP * HEAD_DIM
IN_W = A_Q_W + 2 * A_KV_W + 3 * B_W + N_BRANCHES * D_MODEL

kernel_name = "hybrid_gqa_axialrope_dilated_swa_griffin_merge"


def rms_norm(x, g):
    x32 = x.astype(jnp.float32)
    y = x32 * lax.rsqrt(jnp.mean(x32 * x32, axis=-1, keepdims=True) + EPS)
    return y.astype(x.dtype) * g


def rotate(xh, ang):
    half = xh.shape[-1] // 2
    x1, x2 = xh[..., :half], xh[..., half:]
    c = jnp.cos(ang)[None, :, None, :].astype(xh.dtype)
    s = jnp.sin(ang)[None, :, None, :].astype(xh.dtype)
    return jnp.concatenate([x1 * c - x2 * s, x2 * c + x1 * s], axis=-1)


def axial_rope(x, ang_row, ang_col):
    return jnp.concatenate([rotate(x[..., :AXIS_ROPE_DIM], ang_row),
                            rotate(x[..., AXIS_ROPE_DIM:], ang_col)], axis=-1)


def axial_angles(seq):
    rows = seq // GRID_W
    row = jnp.broadcast_to(jnp.arange(rows)[:, None], (rows, GRID_W)).reshape(-1).astype(jnp.float32)
    col = jnp.broadcast_to(jnp.arange(GRID_W)[None, :], (rows, GRID_W)).reshape(-1).astype(jnp.float32)
    inv = ROPE_THETA ** (-jnp.arange(0, AXIS_ROPE_DIM, 2, dtype=jnp.float32) / AXIS_ROPE_DIM)
    return row[:, None] * inv, col[:, None] * inv


def t5_bucket(rel):
    nb = REL_BUCKETS // 2
    max_exact = nb // 2
    side = jnp.where(rel > 0, nb, 0)
    n = jnp.abs(rel)
    nf = jnp.maximum(n, 1).astype(jnp.float32)
    large = max_exact + (jnp.log(nf / max_exact) / math.log(REL_MAX_DIST / max_exact)
                         * (nb - max_exact)).astype(jnp.int32)
    large = jnp.minimum(large, nb - 1)
    return side + jnp.where(n < max_exact, n, large)


def grid_attention(q, k, v):
    b, s = q.shape[:2]
    nb = s // Q_BLOCK
    qg = q.reshape(b, nb, Q_BLOCK, N_A_KV_HEADS, N_A_GROUP, HEAD_DIM).swapaxes(0, 1)
    k32 = k.astype(jnp.float32)
    scale = HEAD_DIM ** -0.5

    def one_block(qb):
        logits = jnp.einsum('bqkgd,bskd->bkgqs', qb.astype(jnp.float32), k32) * scale
        p = jax.nn.softmax(logits, axis=-1).astype(v.dtype)
        return jnp.einsum('bkgqs,bskd->bqkgd', p, v)

    o = lax.map(one_block, qg)
    return o.swapaxes(0, 1).reshape(b, s, A_Q_W)


def dilated_attention(q, k, v, rel_bias):
    b, s = q.shape[:2]
    nb = s // Q_BLOCK
    scale = HEAD_DIM ** -0.5
    offs, biases = [], []
    for g, (window, dil) in enumerate(B_PATTERNS):
        radius = window // (2 * dil)
        off = jnp.arange(-radius, radius + 1, dtype=jnp.int32) * dil
        offs.append(off)
        tab = rel_bias[t5_bucket(off)][:, g * N_B_HEADS_PER_GROUP:(g + 1) * N_B_HEADS_PER_GROUP]
        biases.append(tab.T.astype(jnp.float32))
    k_groups = [k[:, :, g].astype(jnp.float32) for g in range(N_B_GROUPS)]
    v_groups = [v[:, :, g] for g in range(N_B_GROUPS)]

    def one_block(i):
        t0 = i * Q_BLOCK
        tq = t0 + jnp.arange(Q_BLOCK, dtype=jnp.int32)
        qb = lax.dynamic_slice_in_dim(q, t0, Q_BLOCK, axis=1).astype(jnp.float32)
        outs, lses = [], []
        for g in range(N_B_GROUPS):
            idx = tq[:, None] + offs[g][None, :]
            valid = (idx >= 0) & (idx < s)
            idxc = jnp.clip(idx, 0, s - 1)
            kg = jnp.take(k_groups[g], idxc, axis=1)
            vg = jnp.take(v_groups[g], idxc, axis=1)
            logits = jnp.einsum('bqhd,bqjhd->bhqj', qb[:, :, g], kg) * scale + biases[g][None, :, None, :]
            logits = jnp.where(valid[None, None], logits, NEG_INF)
            lse = jax.nn.logsumexp(logits, axis=-1)
            p = jnp.exp(logits - lse[..., None]).astype(v.dtype)
            outs.append(jnp.einsum('bhqj,bqjhd->bqhd', p, vg))
            lses.append(lse)
        w = jax.nn.softmax(jnp.stack(lses, axis=0), axis=0)
        w = jnp.swapaxes(w, 2, 3).astype(v.dtype)
        return jnp.einsum('gbqh,gbqhd->bqhd', w, jnp.stack(outs, axis=0))

    o = lax.map(one_block, jnp.arange(nb, dtype=jnp.int32))
    return o.swapaxes(0, 1).reshape(b, s, B_OUT_W)


def setup_inputs(seed: int = 0) -> dict:
    key = jax.random.key(seed)
    ks = jax.random.split(key, 16)
    f32 = jnp.float32

    def nrm(k, shape, scale):
        return jax.random.normal(k, shape, f32) * scale

    return {
        "x": nrm(ks[0], (BATCH, SEQ, D_MODEL), 1.0),
        "norm1_g": 1.0 + nrm(ks[1], (DEPTH, D_MODEL), 0.02),
        "w_in": nrm(ks[2], (DEPTH, D_MODEL, IN_W), D_MODEL ** -0.5),
        "b_gate": nrm(ks[3], (DEPTH, N_BRANCHES, D_MODEL), 0.02),
        "q_norm_a": 1.0 + nrm(ks[4], (DEPTH, HEAD_DIM), 0.02),
        "k_norm_a": 1.0 + nrm(ks[5], (DEPTH, HEAD_DIM), 0.02),
        "q_norm_b": 1.0 + nrm(ks[6], (DEPTH, HEAD_DIM), 0.02),
        "k_norm_b": 1.0 + nrm(ks[7], (DEPTH, HEAD_DIM), 0.02),
        "rel_bias": nrm(ks[8], (REL_BUCKETS, N_B_HEADS), 0.2),
        "w_proj_a": nrm(ks[9], (DEPTH, A_Q_W, D_MODEL), A_Q_W ** -0.5),
        "w_proj_b": nrm(ks[10], (DEPTH, B_OUT_W, D_MODEL), B_OUT_W ** -0.5),
        "w_out": nrm(ks[11], (DEPTH, D_MODEL, D_MODEL), D_MODEL ** -0.5),
        "norm2_g": 1.0 + nrm(ks[12], (DEPTH, D_MODEL), 0.02),
        "w_ffn_gate": nrm(ks[13], (DEPTH, D_MODEL, D_FF), D_MODEL ** -0.5),
        "w_ffn_up": nrm(ks[14], (DEPTH, D_MODEL, D_FF), D_MODEL ** -0.5),
        "w_ffn_down": nrm(ks[15], (DEPTH, D_FF, D_MODEL), D_FF ** -0.5),
    }


def reference(x, norm1_g, w_in, b_gate, q_norm_a, k_norm_a, q_norm_b, k_norm_b, rel_bias,
              w_proj_a, w_proj_b, w_out, norm2_g, w_ffn_gate, w_ffn_up, w_ffn_down):
    b, s, _ = x.shape
    ang_row, ang_col = axial_angles(s)
    splits = [int(c) for c in np.cumsum([A_Q_W, A_KV_W, A_KV_W, B_W, B_W, B_W, D_MODEL])]
    b_shape = (b, s, N_B_GROUPS, N_B_HEADS_PER_GROUP, HEAD_DIM)
    for l in range(DEPTH):
        h = rms_norm(x, norm1_g[l])
        proj = h @ w_in[l]
        qa, ka, va, qb, kb, vb, ga, gb = jnp.split(proj, splits, axis=-1)
        qa = axial_rope(rms_norm(qa.reshape(b, s, N_A_HEADS, HEAD_DIM), q_norm_a[l]), ang_row, ang_col)
        ka = axial_rope(rms_norm(ka.reshape(b, s, N_A_KV_HEADS, HEAD_DIM), k_norm_a[l]), ang_row, ang_col)
        va = va.reshape(b, s, N_A_KV_HEADS, HEAD_DIM)
        o_a = grid_attention(qa, ka, va)
        qb = rms_norm(qb.reshape(b_shape), q_norm_b[l])
        kb = rms_norm(kb.reshape(b_shape), k_norm_b[l])
        vb = vb.reshape(b_shape)
        o_b = dilated_attention(qb, kb, vb, rel_bias)
        gate_a = jax.nn.sigmoid(ga + b_gate[l, 0])
        gate_b = jax.nn.sigmoid(gb + b_gate[l, 1])
        merged = gate_a * (o_a @ w_proj_a[l]) + gate_b * (o_b @ w_proj_b[l])
        x = x + merged @ w_out[l]
        h = rms_norm(x, norm2_g[l])
        x = x + (jax.nn.silu(h @ w_ffn_gate[l]) * (h @ w_ffn_up[l])) @ w_ffn_down[l]
    return x
```

```cpp
#include <hip/hip_runtime.h>
#include <hip/hip_cooperative_groups.h>
#include <hip/hip_bf16.h>
#include <cstdio>
#include <cstdint>
namespace cg = cooperative_groups;

constexpr int BATCH = 4, SEQ = 2048, TOK = BATCH * SEQ, DM = 4096, INW = 15872, DFF = 11008, NGU = 2 * DFF;
constexpr int C_QA = 0, C_KA = 2048, C_VA = 2560, C_QB = 3072, C_KB = 4608, C_VB = 6144, C_GA = 7680, C_GB = 11776;
constexpr float EPS = 1e-6f;

namespace pg8 {
#define PG8_LAS __attribute__((address_space(3)))
typedef unsigned short bf16_t;
typedef short bf16x8 __attribute__((ext_vector_type(8)));
typedef float f32x4 __attribute__((ext_vector_type(4)));
typedef unsigned u32x4 __attribute__((ext_vector_type(4)));
constexpr int BM = 256, BK = 64, HALF = 128, HTB = HALF * BK * 2  , STAGE_BYTES = 8 * HTB, NXCD = 8, WGM = 8;

__host__ __device__ __forceinline__ int lds_byte(int r, int c) { const int st = (r >> 4) * 2 + (c >> 5), rr = r & 15, cc = c & 31, ob = rr * 64 + cc * 2; return st * 1024 + (ob ^ (((ob >> 9) & 1) << 5)); }
__host__ __device__ __forceinline__ void stage_rc(int b, int& R, int& C) { const int st = b / 1024, sb = b % 1024, swz = sb ^ (((sb >> 9) & 1) << 5); R = (st >> 1) * 16 + swz / 64; C = (st & 1) * 32 + (swz % 64) / 2; }
__host__ __device__ __forceinline__ int perm32(int rho) { const int n = rho >> 4, i = rho & 15; return 8 * (i >> 2) + 4 * n + (i & 3); }

struct Unit { int pm, pn; };
struct Gemm { const bf16_t* A; const bf16_t* Bt; int M, N, K; };

struct StaticOrder {
    int nM, nN, nwg, G, c;
    __host__ __device__ void init(int M, int N, int G_, int c_) { nM = M / BM; nN = N / BM; nwg = nM * nN; G = G_; c = c_; }
    __host__ __device__ bool next(int i, Unit& u) const {
        const long L = (long)i * G + c; if (L >= nwg) return false;
        int wgid = (int)L; { const int q = nwg / NXCD, r = nwg % NXCD, xcd = wgid % NXCD, off = wgid / NXCD; wgid = (xcd < r ? xcd * (q + 1) : r * (q + 1) + (xcd - r) * q) + off; }
        const int nig = WGM * nN, gid = wgid / nig, fm = gid * WGM, gsz = (nM - fm) < WGM ? (nM - fm) : WGM;
        u.pm = fm + ((wgid % nig) % gsz); u.pn = (wgid % nig) / gsz; return true;
    }
    __device__ __forceinline__ void a_ready(const Unit&) const {}
    __device__ __forceinline__ void done(const Unit&) const {}
};

__device__ __forceinline__ unsigned cvt_pk_bf16(float lo, float hi) { unsigned r; asm volatile("v_cvt_pk_bf16_f32 %0, %1, %2" : "=v"(r) : "v"(lo), "v"(hi)); return r; }
__device__ __forceinline__ float sigmoidf_(float x) { return __builtin_amdgcn_rcpf(1.f + __expf(-x)); }
__device__ __forceinline__ float bf_lo(unsigned w) { return __uint_as_float(w << 16); }
__device__ __forceinline__ float bf_hi(unsigned w) { return __uint_as_float(w & 0xffff0000u); }
__device__ __forceinline__ u32x4 pack8(const f32x4 v0, const f32x4 v1) { u32x4 w; w.x = cvt_pk_bf16(v0[0], v0[1]); w.y = cvt_pk_bf16(v0[2], v0[3]); w.z = cvt_pk_bf16(v1[0], v1[1]); w.w = cvt_pk_bf16(v1[2], v1[3]); return w; }
__device__ __forceinline__ void unpack8(const u32x4 w, f32x4& v0, f32x4& v1) { v0 = (f32x4){bf_lo(w.x), bf_hi(w.x), bf_lo(w.y), bf_hi(w.y)}; v1 = (f32x4){bf_lo(w.z), bf_hi(w.z), bf_lo(w.w), bf_hi(w.w)}; }

struct EpiIn {
    static constexpr bool PERM = true, AFTER_DRAIN = false, HOOK = false;
    bf16_t* O; bf16_t* KVA; const float* bgate; const float *normw, *rope; PG8_LAS float* part;
    __device__ __forceinline__ void operator()(const f32x4 (&acc)[2][2][4][2], const Unit& u, int wr, int wc, int fr, int fq) const {
        const int row0 = u.pm * BM + wr * 64 + fr, col0 = u.pn * BM + wc * 32 + 8 * fq;
        const int pn = u.pn;
        const bool gate = (pn >= 30), normed = (pn < 10) || (pn >= 12 && pn < 24), ahead = pn < 10;
        if (normed) {
#pragma unroll
            for (int ai = 0; ai < 2; ++ai)
#pragma unroll
                for (int m = 0; m < 4; ++m)
#pragma unroll
                    for (int bj = 0; bj < 2; ++bj) { const f32x4 v0 = acc[ai][bj][m][0], v1 = acc[ai][bj][m][1];
                        float ss = (v0[0] * v0[0] + v0[1] * v0[1]) + (v0[2] * v0[2] + v0[3] * v0[3]) + (v1[0] * v1[0] + v1[1] * v1[1]) + (v1[2] * v1[2] + v1[3] * v1[3]);
                        ss += __shfl_xor(ss, 16); ss += __shfl_xor(ss, 32);
                        if (fq == 0) part[(ai * HALF + wr * 64 + m * 16 + fr) * 8 + bj * 4 + wc] = ss; }
            asm volatile("s_waitcnt lgkmcnt(0)" ::: "memory"); __builtin_amdgcn_s_barrier(); asm volatile("" ::: "memory");
            const float* wn = normw + (pn < 8 ? 0 : (pn < 10 ? 128 : (pn < 18 ? 256 : 384)));
            const int half = wc >> 1, qq = (wc & 1) * 4 + fq;
            const f32x4 w0 = ahead ? *(const f32x4*)(wn + half * 64 + 4 * qq) : *(const f32x4*)(wn + wc * 32 + 8 * fq);
            const f32x4 w1 = ahead ? *(const f32x4*)(wn + half * 64 + 32 + 4 * qq) : *(const f32x4*)(wn + wc * 32 + 8 * fq + 4);
#pragma unroll
            for (int ai = 0; ai < 2; ++ai)
#pragma unroll
                for (int m = 0; m < 4; ++m) { const int rl = ai * HALF + wr * 64 + m * 16 + fr, row = u.pm * BM + rl; bf16_t* rowp = O + (size_t)row * INW + col0;
                    f32x4 cs0 = {1.f, 0.f, 1.f, 0.f}, cs1 = {1.f, 0.f, 1.f, 0.f};
                    if (ahead) { const int t = row & (SEQ - 1), pos = half ? (t & 63) : (t >> 6); const float* rt = rope + ((size_t)pos * 32 + 4 * qq) * 2; cs0 = *(const f32x4*)rt; cs1 = *(const f32x4*)(rt + 4); }
#pragma unroll
                    for (int bj = 0; bj < 2; ++bj) { const f32x4 p4 = *(const PG8_LAS f32x4*)(part + rl * 8 + bj * 4);
                        const float rstd = __builtin_amdgcn_rsqf(((p4[0] + p4[1]) + (p4[2] + p4[3])) * (1.0f / 128.f) + EPS);
                        f32x4 v0 = acc[ai][bj][m][0] * rstd * w0, v1 = acc[ai][bj][m][1] * rstd * w1;
                        if (ahead) { const f32x4 c = {cs0[0], cs0[2], cs1[0], cs1[2]}, sn = {cs0[1], cs0[3], cs1[1], cs1[3]};
                            const f32x4 lo = v0 * c - v1 * sn, hi = v1 * c + v0 * sn; v0 = lo; v1 = hi; }
                        bf16_t* dst = (pn >= 8 && pn < 12) ? KVA + (((size_t)(row >> 11) * 8 + (pn - 8) * 2 + bj) * SEQ + (row & (SEQ - 1))) * 128 + wc * 32 + 8 * fq : rowp + bj * HALF;
                        *(u32x4*)dst = pack8(v0, v1); } }
            return;
        }
        f32x4 bv[2][2];
#pragma unroll
        for (int bj = 0; bj < 2; ++bj)
#pragma unroll
            for (int n = 0; n < 2; ++n) bv[bj][n] = gate ? *(const f32x4*)(bgate + (col0 - C_GA) + bj * HALF + 4 * n) : (f32x4){0.f, 0.f, 0.f, 0.f};
#pragma unroll
        for (int ai = 0; ai < 2; ++ai)
#pragma unroll
            for (int m = 0; m < 4; ++m) { const int row = row0 + ai * HALF + m * 16; bf16_t* rowp = O + (size_t)row * INW + col0;
#pragma unroll
                for (int bj = 0; bj < 2; ++bj) { f32x4 v0 = acc[ai][bj][m][0], v1 = acc[ai][bj][m][1];
                    if (gate) { v0 += bv[bj][0]; v1 += bv[bj][1];
#pragma unroll
                        for (int e = 0; e < 4; ++e) { v0[e] = sigmoidf_(v0[e]); v1[e] = sigmoidf_(v1[e]); } }
                    bf16_t* dst = (pn >= 8 && pn < 12) ? KVA + (((size_t)(row >> 11) * 8 + (pn - 8) * 2 + bj) * SEQ + (row & (SEQ - 1))) * 128 + wc * 32 + 8 * fq : rowp + bj * HALF;
                    *(u32x4*)dst = pack8(v0, v1); } }
    }
};
struct EpiMerge {
    static constexpr bool PERM = true, AFTER_DRAIN = false, HOOK = true;
    const bf16_t* P; bf16_t* MG; int hook_t;
    __device__ __forceinline__ void hook(f32x4 (&acc)[2][2][4][2], const Unit& u, int wr, int wc, int fr, int fq) const {
        int row0 = u.pm * BM + wr * 64 + fr, col0 = u.pn * BM + wc * 32 + 8 * fq;
        asm volatile("" : "+v"(row0), "+v"(col0));
#pragma unroll
        for (int ai = 0; ai < 2; ++ai)
#pragma unroll
            for (int m = 0; m < 4; ++m) { const size_t row = (size_t)(row0 + ai * HALF + m * 16);
#pragma unroll
                for (int bj = 0; bj < 2; ++bj) { const int col = col0 + bj * HALF;
                    f32x4 a0, a1, b0, b1; unpack8(*(const u32x4*)(P + row * INW + C_GA + col), a0, a1); unpack8(*(const u32x4*)(P + row * INW + C_GB + col), b0, b1);
#pragma unroll
                    for (int e = 0; e < 4; ++e) { acc[ai][bj][m][0][e] *= a0[e] * __builtin_amdgcn_rcpf(fmaxf(b0[e], 1e-30f)); acc[ai][bj][m][1][e] *= a1[e] * __builtin_amdgcn_rcpf(fmaxf(b1[e], 1e-30f)); }
                    asm volatile("" ::: "memory"); } }
    }
    __device__ __forceinline__ void operator()(const f32x4 (&acc)[2][2][4][2], const Unit& u, int wr, int wc, int fr, int fq) const {
        const int row0 = u.pm * BM + wr * 64 + fr, col0 = u.pn * BM + wc * 32 + 8 * fq;
#pragma unroll
        for (int ai = 0; ai < 2; ++ai)
#pragma unroll
            for (int m = 0; m < 4; ++m) { const size_t row = (size_t)(row0 + ai * HALF + m * 16);
#pragma unroll
                for (int bj = 0; bj < 2; ++bj) { const int col = col0 + bj * HALF;
                    f32x4 g0, g1; unpack8(*(const u32x4*)(P + row * INW + C_GB + col), g0, g1);
                    *(u32x4*)(MG + row * DM + col) = pack8(acc[ai][bj][m][0] * g0, acc[ai][bj][m][1] * g1); } }
    }
};
struct EpiOut {
    static constexpr bool PERM = true, AFTER_DRAIN = false, HOOK = false;
    const float* x; float* out; bf16_t* XB; float* sumsq;
    __device__ __forceinline__ void operator()(const f32x4 (&acc)[2][2][4][2], const Unit& u, int wr, int wc, int fr, int fq) const {
        const int row0 = u.pm * BM + wr * 64 + fr, col0 = u.pn * BM + wc * 32 + 8 * fq;
#pragma unroll
        for (int ai = 0; ai < 2; ++ai)
#pragma unroll
            for (int m = 0; m < 4; ++m) { const size_t row = (size_t)(row0 + ai * HALF + m * 16); float ss = 0.f;
#pragma unroll
                for (int bj = 0; bj < 2; ++bj) { const int col = col0 + bj * HALF;
                    const f32x4 v0 = acc[ai][bj][m][0] + *(const f32x4*)(x + row * DM + col), v1 = acc[ai][bj][m][1] + *(const f32x4*)(x + row * DM + col + 4);
                    *(u32x4*)(XB + row * DM + col) = pack8(v0, v1);
                    ss += (v0[0] * v0[0] + v0[1] * v0[1]) + (v0[2] * v0[2] + v0[3] * v0[3]) + (v1[0] * v1[0] + v1[1] * v1[1]) + (v1[2] * v1[2] + v1[3] * v1[3]); }
                ss += __shfl_xor(ss, 16); ss += __shfl_xor(ss, 32);
                if (fq == 0) atomicAdd(sumsq + row, ss); }
    }
};
struct EpiGU {
    static constexpr bool PERM = true, AFTER_DRAIN = false, HOOK = false;
    const float* sumsq; bf16_t* ACT;
    __device__ __forceinline__ void operator()(const f32x4 (&acc)[2][2][4][2], const Unit& u, int wr, int wc, int fr, int fq) const {
        const int row0 = u.pm * BM + wr * 64 + fr, col0 = u.pn * HALF + wc * 32 + 8 * fq;
        const __attribute__((address_space(1))) float* ssq = (const __attribute__((address_space(1))) float*)sumsq;
        float sq[2][4];
#pragma unroll
        for (int ai = 0; ai < 2; ++ai)
#pragma unroll
            for (int m = 0; m < 4; ++m) sq[ai][m] = ssq[row0 + ai * HALF + m * 16];
#pragma unroll
        for (int ai = 0; ai < 2; ++ai)
#pragma unroll
            for (int m = 0; m < 4; ++m) { const size_t row = (size_t)(row0 + ai * HALF + m * 16);
                const float rstd = __builtin_amdgcn_rsqf(sq[ai][m] * (1.0f / DM) + EPS);
                f32x4 o[2];
#pragma unroll
                for (int n = 0; n < 2; ++n)
#pragma unroll
                    for (int e = 0; e < 4; ++e) { const float g = acc[ai][0][m][n][e] * rstd, uu = acc[ai][1][m][n][e] * rstd; o[n][e] = g * sigmoidf_(g) * uu; }
                *(u32x4*)(ACT + row * DFF + col0) = pack8(o[0], o[1]); }
    }
};
struct EpiDown {
    static constexpr bool PERM = true, AFTER_DRAIN = false, HOOK = false;
    const bf16_t* XB; float* out;
    __device__ __forceinline__ void operator()(const f32x4 (&acc)[2][2][4][2], const Unit& u, int wr, int wc, int fr, int fq) const {
        const int row0 = u.pm * BM + wr * 64 + fr, col0 = u.pn * BM + wc * 32 + 8 * fq;
#pragma unroll
        for (int ai = 0; ai < 2; ++ai)
#pragma unroll
            for (int m = 0; m < 4; ++m) { const size_t row = (size_t)(row0 + ai * HALF + m * 16);
#pragma unroll
                for (int bj = 0; bj < 2; ++bj) { const size_t off = row * DM + col0 + bj * HALF;
                    f32x4 a0, a1; unpack8(*(const u32x4*)(XB + off), a0, a1);
                    *(f32x4*)(out + off) = a0 + acc[ai][bj][m][0]; *(f32x4*)(out + off + 4) = a1 + acc[ai][bj][m][1]; } }
    }
};
template <class Epi, class Sched, bool ALIGN_EPI = false, bool SP2 = false>
__device__ __forceinline__ void gemm_phase(PG8_LAS unsigned char* lds, const Gemm g, const Sched& S, const Epi& E, int tid_l) {
    const int tid = tid_l, wid = __builtin_amdgcn_readfirstlane(tid >> 6), lane = tid & 63, wr = wid >> 2, wc = wid & 3, fr = lane & 15, fq = lane >> 4;
    const int K = g.K, nt = K / BK;
    unsigned voffA[2], voffB[2];
#pragma unroll
    for (int i = 0; i < 2; ++i) { int R, C; stage_rc(tid * 16 + i * 8192, R, C); const int Rb = Epi::PERM ? ((R & ~31) + perm32(R & 31)) : R;
        voffA[i] = (unsigned)(R * K + C) * 2u; voffB[i] = (unsigned)(Rb * K + C) * 2u; }
    const size_t kstep = (size_t)(BK * 2);
    const size_t hstep = (size_t)HALF * K * 2;
    const size_t tstep = 2 * hstep;
    const unsigned ldsw = (unsigned)wid * 1024u;
    const int aoff = lds_byte(wr * 64 + fr, fq * 8), boff = lds_byte(wc * 32 + fr, fq * 8);
#define PG8_SA(b, h) (((b) * 2 + (h)) * HTB)
#define PG8_SB(b, h) ((4 + (b) * 2 + (h)) * HTB)
#define PG8_STAGE(bufoff, gbase, voff) do { _Pragma("unroll") for (int _i = 0; _i < 2; ++_i) \
        __builtin_amdgcn_global_load_lds((const unsigned*)((const char*)(gbase) + (voff)[_i]), (PG8_LAS unsigned*)(lds + (bufoff) + ldsw + _i * 8192), 16, 0, 0); } while (0)
#define PG8_LDA(dst, b, h) do { _Pragma("unroll") for (int m = 0; m < 4; ++m) _Pragma("unroll") for (int k = 0; k < 2; ++k) dst[m][k] = *(const PG8_LAS bf16x8*)(lds + PG8_SA(b, h) + aoff + m * 2048 + k * 1024); } while (0)
#define PG8_LDB(dst, b, h) do { _Pragma("unroll") for (int n = 0; n < 2; ++n) _Pragma("unroll") for (int k = 0; k < 2; ++k) dst[n][k] = *(const PG8_LAS bf16x8*)(lds + PG8_SB(b, h) + boff + n * 2048 + k * 1024); } while (0)
#define PG8_MMA(ai, bj, At, Bt) do { __builtin_amdgcn_s_setprio(1); _Pragma("unroll") for (int m = 0; m < 4; ++m) _Pragma("unroll") for (int n = 0; n < 2; ++n) _Pragma("unroll") for (int k = 0; k < 2; ++k) \
        acc[ai][bj][m][n] = __builtin_amdgcn_mfma_f32_16x16x32_bf16(Bt[n][k], At[m][k], acc[ai][bj][m][n], 0, 0, 0); __builtin_amdgcn_s_setprio(0); } while (0)
#define PG8_WAIT_V(n) asm volatile("s_waitcnt vmcnt(" #n ")" ::: "memory")
#define PG8_WAIT_L(n) asm volatile("s_waitcnt lgkmcnt(" #n ")" ::: "memory")
#define PG8_BAR __builtin_amdgcn_s_barrier()
#define PG8_SCHED __builtin_amdgcn_sched_barrier(0)
    Unit cur, nxt; int ui = 0;
    if (!S.next(0, cur)) return;
    f32x4 acc[2][2][4][2];
#pragma unroll
    for (int a = 0; a < 2; ++a)
#pragma unroll
        for (int b = 0; b < 2; ++b)
#pragma unroll
            for (int m = 0; m < 4; ++m)
#pragma unroll
                for (int n = 0; n < 2; ++n) acc[a][b][m][n] = (f32x4){0.f, 0.f, 0.f, 0.f};
    bf16x8 At[4][2], B0[2][2], B1[2][2];
    const char* cA = (const char*)g.A + (size_t)cur.pm * tstep; const char* cB = (const char*)g.Bt + (size_t)cur.pn * tstep;
    S.a_ready(cur);
    if constexpr (SP2) {
        PG8_STAGE(PG8_SB(0, 0), cB, voffB); PG8_STAGE(PG8_SB(0, 1), cB + hstep, voffB); PG8_STAGE(PG8_SA(0, 0), cA, voffA); PG8_STAGE(PG8_SA(0, 1), cA + hstep, voffA);
        if (wr == 1) PG8_BAR;
        PG8_WAIT_V(2); PG8_BAR;
        PG8_STAGE(PG8_SB(1, 0), cB + kstep, voffB); PG8_STAGE(PG8_SA(1, 0), cA + kstep, voffA); PG8_STAGE(PG8_SB(1, 1), cB + hstep + kstep, voffB);
        PG8_WAIT_V(6); PG8_BAR;
    } else {
        PG8_STAGE(PG8_SB(0, 0), cB, voffB); PG8_STAGE(PG8_SA(0, 0), cA, voffA); PG8_STAGE(PG8_SB(0, 1), cB + hstep, voffB); PG8_STAGE(PG8_SA(0, 1), cA + hstep, voffA);
        if (wr == 1) PG8_BAR;
        PG8_WAIT_V(4); PG8_BAR;
        PG8_STAGE(PG8_SB(1, 0), cB + kstep, voffB); PG8_STAGE(PG8_SA(1, 0), cA + kstep, voffA); PG8_STAGE(PG8_SB(1, 1), cB + hstep + kstep, voffB);
        PG8_WAIT_V(6); PG8_BAR;
    }
    for (;;) {
        const bool has_next = S.next(ui + 1, nxt);
        const char* nA = has_next ? (const char*)g.A + (size_t)nxt.pm * tstep : cA; const char* nB = has_next ? (const char*)g.Bt + (size_t)nxt.pn * tstep : cB;
        for (int t = 0; t < nt; t += 2) {
            if constexpr (Epi::HOOK) { if (t == E.hook_t) E.hook(acc, cur, wr, wc, fr, fq); }
            const bool last = (t == nt - 2);
            const char* a1 = cA + (size_t)(t + 1) * kstep;
            const char* a2 = last ? nA : cA + (size_t)(t + 2) * kstep; const char* b2 = last ? nB : cB + (size_t)(t + 2) * kstep;
            const char* a3 = a2 + kstep; const char* b3 = b2 + kstep;
            if (last && has_next) S.a_ready(nxt);
            if constexpr (SP2) {
            PG8_LDB(B0, 0, 0); PG8_LDB(B1, 0, 1); PG8_SCHED; PG8_LDA(At, 0, 0); PG8_STAGE(PG8_SA(1, 1), a1 + hstep, voffA);
            PG8_WAIT_V(8); PG8_WAIT_L(0); PG8_BAR; PG8_MMA(0, 0, At, B0); PG8_MMA(0, 1, At, B1); PG8_BAR; PG8_SCHED;
            PG8_LDA(At, 0, 1); PG8_STAGE(PG8_SB(0, 0), b2, voffB); PG8_STAGE(PG8_SB(0, 1), b2 + hstep, voffB); PG8_STAGE(PG8_SA(0, 0), a2, voffA);
            PG8_WAIT_V(8); PG8_WAIT_L(0); PG8_BAR; PG8_MMA(1, 0, At, B0); PG8_MMA(1, 1, At, B1); PG8_BAR; PG8_SCHED;
            PG8_LDB(B0, 1, 0); PG8_LDB(B1, 1, 1); PG8_SCHED; PG8_LDA(At, 1, 0); PG8_STAGE(PG8_SA(0, 1), a2 + hstep, voffA);
            PG8_WAIT_V(8); PG8_WAIT_L(0); PG8_BAR; PG8_MMA(0, 0, At, B0); PG8_MMA(0, 1, At, B1); PG8_BAR; PG8_SCHED;
            PG8_LDA(At, 1, 1); PG8_STAGE(PG8_SB(1, 0), b3, voffB); PG8_STAGE(PG8_SB(1, 1), b3 + hstep, voffB); PG8_STAGE(PG8_SA(1, 0), a3, voffA);
            PG8_WAIT_V(8); PG8_WAIT_L(0); PG8_BAR; PG8_MMA(1, 0, At, B0); PG8_MMA(1, 1, At, B1); PG8_BAR; PG8_SCHED;
            } else {
            PG8_LDB(B0, 0, 0); PG8_SCHED; PG8_LDA(At, 0, 0); PG8_STAGE(PG8_SA(1, 1), a1 + hstep, voffA);
            PG8_WAIT_L(8); PG8_BAR; PG8_WAIT_L(0); PG8_MMA(0, 0, At, B0); PG8_BAR; PG8_SCHED;
            PG8_LDB(B1, 0, 1); PG8_STAGE(PG8_SB(0, 0), b2, voffB);
            PG8_BAR; PG8_WAIT_L(0); PG8_MMA(0, 1, At, B1); PG8_BAR;
            PG8_LDA(At, 0, 1); PG8_STAGE(PG8_SA(0, 0), a2, voffA);
            PG8_BAR; PG8_WAIT_L(0); PG8_MMA(1, 0, At, B0); PG8_BAR; PG8_SCHED;
            PG8_STAGE(PG8_SB(0, 1), b2 + hstep, voffB);
            PG8_WAIT_V(6); PG8_BAR; PG8_MMA(1, 1, At, B1); PG8_BAR;
            PG8_LDB(B0, 1, 0); PG8_SCHED; PG8_LDA(At, 1, 0); PG8_STAGE(PG8_SA(0, 1), a2 + hstep, voffA);
            PG8_WAIT_L(8); PG8_BAR; PG8_WAIT_L(0); PG8_MMA(0, 0, At, B0); PG8_BAR; PG8_SCHED;
            PG8_LDB(B1, 1, 1); PG8_STAGE(PG8_SB(1, 0), b3, voffB);
            PG8_BAR; PG8_WAIT_L(0); PG8_MMA(0, 1, At, B1); PG8_BAR;
            PG8_LDA(At, 1, 1); PG8_STAGE(PG8_SA(1, 0), a3, voffA);
            PG8_BAR; PG8_WAIT_L(0); PG8_MMA(1, 0, At, B0); PG8_BAR; PG8_SCHED;
            PG8_STAGE(PG8_SB(1, 1), b3 + hstep, voffB);
            PG8_WAIT_V(6); PG8_BAR; PG8_MMA(1, 1, At, B1); PG8_BAR;
            }
        }
        if constexpr (ALIGN_EPI) { if (wr == 0) PG8_BAR; }
        if constexpr (!Epi::AFTER_DRAIN) { E(acc, cur, wr, wc, fr, fq); S.done(cur); }
        if (!has_next) break;
#pragma unroll
        for (int a = 0; a < 2; ++a)
#pragma unroll
            for (int b = 0; b < 2; ++b)
#pragma unroll
                for (int m = 0; m < 4; ++m)
#pragma unroll
                    for (int n = 0; n < 2; ++n) acc[a][b][m][n] = (f32x4){0.f, 0.f, 0.f, 0.f};
        cur = nxt; cA = nA; cB = nB; ++ui;
        if constexpr (ALIGN_EPI) { if (wr == 1) PG8_BAR; }
    }
    PG8_WAIT_V(0);
    if constexpr (!ALIGN_EPI) { if (wr == 0) PG8_BAR; }
    PG8_BAR;
    if constexpr (Epi::AFTER_DRAIN) { E.fused(acc, cur, wr, wc, fr, fq, lds, wid, lane); S.done(cur); }
#undef PG8_SA
#undef PG8_SB
#undef PG8_STAGE
#undef PG8_LDA
#undef PG8_LDB
#undef PG8_MMA
#undef PG8_WAIT_V
#undef PG8_WAIT_L
#undef PG8_BAR
#undef PG8_SCHED
}
}
namespace att {
using bf16 = __hip_bfloat16;
constexpr int D = 128, NW = 8, QBLK = 32, KVBLK = 64;
constexpr float SCALE = 0.088388347648318440f;
constexpr float THR = 8.f;
constexpr int SDEPTH = 2;
constexpr size_t SHM_V = KVBLK * D * 2, SHM_K = KVBLK * D * 2, SHM_ATTN = 2 * SHM_V + 2 * SHM_K + NW * 64 * 4;
using bf16x8 = __attribute__((ext_vector_type(8))) short;
using s16x4  = __attribute__((ext_vector_type(4))) short;
using f32x16 = __attribute__((ext_vector_type(16))) float;
using f32x8  = __attribute__((ext_vector_type(8))) float;
using u32x4  = __attribute__((ext_vector_type(4))) unsigned;
#define KSWZ(row, colB) ((row) * 256 + ((colB) ^ (((row) & 7) << 4)))
#define SBAR() __builtin_amdgcn_sched_barrier(0)
__device__ __forceinline__ int crow(int r, int hi) { return (r & 3) + 8 * (r >> 2) + 4 * hi; }
__device__ __forceinline__ unsigned cvtpk(float lo, float hi) {
  unsigned r; asm volatile("v_cvt_pk_bf16_f32 %0, %1, %2" : "=v"(r) : "v"(lo), "v"(hi)); return r;
}
template <typename TIn> struct Stage;
template <> struct Stage<bf16>  { using T = bf16x8;
  __device__ static __forceinline__ T ld8(const bf16* p) { return *reinterpret_cast<const bf16x8*>(p); }
  __device__ static __forceinline__ bf16x8 tobf(T x) { return x; } };
template <> struct Stage<float> { using T = f32x8;
  __device__ static __forceinline__ T ld8(const float* p) { return *reinterpret_cast<const f32x8*>(p); }
  __device__ static __forceinline__ bf16x8 tobf(T x) {
    u32x4 w = {cvtpk(x[0], x[1]), cvtpk(x[2], x[3]), cvtpk(x[4], x[5]), cvtpk(x[6], x[7])}; return *reinterpret_cast<bf16x8*>(&w); } };

__device__ __forceinline__ void partialSM(f32x16& p0, f32x16& p1, float& m_reg, float& mn, float& alpha) {
  constexpr float C = SCALE * 1.4426950408889634f;
  float pmax = p0[0]; for (int r = 1; r < 16; ++r) pmax = fmaxf(pmax, p0[r]); for (int r = 0; r < 16; ++r) pmax = fmaxf(pmax, p1[r]);
  { auto rr = __builtin_amdgcn_permlane32_swap(__float_as_uint(pmax), __float_as_uint(pmax), false, false);
    pmax = fmaxf(__uint_as_float(rr[0]), __uint_as_float(rr[1])); }
  if (__builtin_expect(__all(pmax - m_reg <= THR / SCALE), 1)) { mn = m_reg; alpha = 1.f; }
  else { mn = fmaxf(m_reg, pmax); alpha = __builtin_amdgcn_exp2f((m_reg - mn) * C); m_reg = mn; }
  float mnC = -mn * C;
  for (int r = 0; r < 16; ++r) p0[r] = fmaf(p0[r], C, mnC); for (int r = 0; r < 16; ++r) p1[r] = fmaf(p1[r], C, mnC);
  for (int r = 0; r < 16; ++r) p0[r] = __builtin_amdgcn_exp2f(p0[r]);
}
__device__ __forceinline__ void finishSM(f32x16& p0, f32x16& p1, float alpha, float& l_reg, bf16x8& pa0, bf16x8& pa1, bf16x8& pa2, bf16x8& pa3) {
  for (int r = 0; r < 16; ++r) p1[r] = __builtin_amdgcn_exp2f(p1[r]);
  float ps = 0; for (int r = 0; r < 16; ++r) ps += p0[r]; for (int r = 0; r < 16; ++r) ps += p1[r];
  { auto rr = __builtin_amdgcn_permlane32_swap(__float_as_uint(ps), __float_as_uint(ps), false, false);
    ps = __uint_as_float(rr[0]) + __uint_as_float(rr[1]); }
  l_reg = l_reg * alpha + ps;
#define PK4(P, BASE, OUT) do { unsigned a0 = cvtpk(P[BASE + 0], P[BASE + 1]), a1 = cvtpk(P[BASE + 2], P[BASE + 3]);   \
    unsigned b0 = cvtpk(P[BASE + 4], P[BASE + 5]), b1 = cvtpk(P[BASE + 6], P[BASE + 7]);                              \
    auto r0 = __builtin_amdgcn_permlane32_swap(a0, b0, false, false); auto r1 = __builtin_amdgcn_permlane32_swap(a1, b1, false, false); \
    u32x4 w = {r0[0], r1[0], r0[1], r1[1]}; OUT = *reinterpret_cast<bf16x8*>(&w); } while (0)
  PK4(p0, 0, pa0); PK4(p0, 8, pa1); PK4(p1, 0, pa2); PK4(p1, 8, pa3);
#undef PK4
}
__device__ __forceinline__ void qkt(f32x16& p0, f32x16& p1, const bf16* Ks, const bf16x8* qr, int r32, int hi) {
  p0 = f32x16{}; p1 = f32x16{};
  for (int d0 = 0; d0 < 8; ++d0) { int cb = (d0 * 16 + hi * 8) * 2;
    bf16x8 b0 = *reinterpret_cast<const bf16x8*>((const char*)Ks + KSWZ(r32, cb));
    bf16x8 b1 = *reinterpret_cast<const bf16x8*>((const char*)Ks + KSWZ(32 + r32, cb));
    p0 = __builtin_amdgcn_mfma_f32_32x32x16_bf16(b0, qr[d0], p0, 0, 0, 0);
    p1 = __builtin_amdgcn_mfma_f32_32x32x16_bf16(b1, qr[d0], p1, 0, 0, 0); }
}
__device__ __forceinline__ int v_st(int k, int c) { const int kk = (k & ~0xC) | ((k & 4) << 1) | ((k & 8) >> 1); return ((kk >> 3) * 4 + (c >> 5)) * 512 + ((kk & 7) * 32 + (c & 31)) * 2; }
__device__ __forceinline__ int v_rd_base(int lane) { return ((lane & 3) << 3) | (((lane >> 2) & 3) << 6) | (((lane >> 4) & 1) << 5) | (((lane >> 5) & 1) << 8); }
constexpr int v_rd_off(int d0, int ks, int half) { return d0 * 512 + ks * 4096 + half * 2048; }
template <int OFF> __device__ __forceinline__ s16x4 tr_read(int vb) {
  s16x4 r; asm volatile("ds_read_b64_tr_b16 %0, %1 offset:%2" : "=&v"(r) : "v"(vb), "i"(OFF) : "memory"); return r;
}
template <int D0> __device__ __forceinline__ void pv_one(f32x16& od, int vb, bf16x8 pa0, bf16x8 pa1, bf16x8 pa2, bf16x8 pa3) {
  const s16x4 l0 = tr_read<v_rd_off(D0, 0, 0)>(vb), h0 = tr_read<v_rd_off(D0, 0, 1)>(vb), l1 = tr_read<v_rd_off(D0, 1, 0)>(vb), h1 = tr_read<v_rd_off(D0, 1, 1)>(vb);
  const s16x4 l2 = tr_read<v_rd_off(D0, 2, 0)>(vb), h2 = tr_read<v_rd_off(D0, 2, 1)>(vb), l3 = tr_read<v_rd_off(D0, 3, 0)>(vb), h3 = tr_read<v_rd_off(D0, 3, 1)>(vb);
  asm volatile("s_waitcnt lgkmcnt(0)" ::: "memory"); SBAR();
#define PK(L, H) (bf16x8){L[0], L[1], L[2], L[3], H[0], H[1], H[2], H[3]}
  od = __builtin_amdgcn_mfma_f32_32x32x16_bf16(pa0, PK(l0, h0), od, 0, 0, 0);
  od = __builtin_amdgcn_mfma_f32_32x32x16_bf16(pa1, PK(l1, h1), od, 0, 0, 0);
  od = __builtin_amdgcn_mfma_f32_32x32x16_bf16(pa2, PK(l2, h2), od, 0, 0, 0);
  od = __builtin_amdgcn_mfma_f32_32x32x16_bf16(pa3, PK(l3, h3), od, 0, 0, 0);
#undef PK
}
__device__ __forceinline__ void pv_d0(f32x16* o, int vb, bf16x8 pa0, bf16x8 pa1, bf16x8 pa2, bf16x8 pa3) {
  pv_one<0>(o[0], vb, pa0, pa1, pa2, pa3); pv_one<1>(o[1], vb, pa0, pa1, pa2, pa3); pv_one<2>(o[2], vb, pa0, pa1, pa2, pa3); pv_one<3>(o[3], vb, pa0, pa1, pa2, pa3);
}

template <int LDQ, int LDK, int LDO>
__device__ __forceinline__ void attn_dense_body(const bf16* __restrict__ Qb, const bf16* __restrict__ Kh, const bf16* __restrict__ Vh,
                                                bf16* __restrict__ Ob, int seq, char* lds, int tid_l) {
  using St = Stage<bf16>;
  const int tid = tid_l, wid = tid >> 6, lane = tid & 63, r32 = lane & 31, hi = lane >> 5;
  bf16* V_lds = (bf16*)lds; bf16* K_lds = (bf16*)(lds + 2 * SHM_V);
  float* ws = (float*)(lds + 2 * SHM_V + 2 * SHM_K) + wid * 64; float* li_l = ws; float* al_l = ws + 32;
  float m_reg = -1e30f, l_reg = 0; f32x16 o[4] = {}; bf16x8 qr[8];
  const bf16* Qw = Qb + (long)(wid * QBLK + r32) * LDQ + hi * 8;
#pragma unroll
  for (int d0 = 0; d0 < 8; ++d0) qr[d0] = St::ld8(Qw + d0 * 16);
  const int sr = tid >> 4, sc = (tid & 15) * 8, vst0 = v_st(sr, sc), vst1 = v_st(32 + sr, sc);
  const int vb0 = (int)(uintptr_t)V_lds + v_rd_base(lane);
  struct { typename St::T vs0, vs1, ks0, ks1; } sr_[SDEPTH];
#define SLOAD(i, k0) do { sr_[i].vs0 = St::ld8(&Vh[(long)((k0) + sr) * LDK + sc]); sr_[i].vs1 = St::ld8(&Vh[(long)((k0) + 32 + sr) * LDK + sc]); \
    sr_[i].ks0 = St::ld8(&Kh[(long)((k0) + sr) * LDK + sc]); sr_[i].ks1 = St::ld8(&Kh[(long)((k0) + 32 + sr) * LDK + sc]); } while (0)
#define SWRITE(b, i) do { *(bf16x8*)((char*)V_lds + (b) * SHM_V + vst0) = St::tobf(sr_[i].vs0);          \
    *(bf16x8*)((char*)V_lds + (b) * SHM_V + vst1) = St::tobf(sr_[i].vs1); int kc = sc * 2;               \
    *(bf16x8*)((char*)K_lds + (b) * SHM_K + KSWZ(sr, kc)) = St::tobf(sr_[i].ks0);                       \
    *(bf16x8*)((char*)K_lds + (b) * SHM_K + KSWZ(32 + sr, kc)) = St::tobf(sr_[i].ks1); } while (0)
#define SWAIT() do { if constexpr (SDEPTH == 2) asm volatile("s_waitcnt vmcnt(4)" ::: "memory"); else asm volatile("s_waitcnt vmcnt(0)" ::: "memory"); } while (0)
#define RESC(a) do { if (__any((a) < 1.f)) { if (hi == 0) al_l[r32] = (a); asm volatile("s_waitcnt lgkmcnt(0)" ::: "memory"); \
    for (int d = 0; d < 4; ++d) for (int r = 0; r < 16; ++r) o[d][r] *= al_l[crow(r, hi)]; } } while (0)
  f32x16 pA0, pA1, pB0, pB1; float mnA, mnB, alA, alB; bf16x8 pa0, pa1, pa2, pa3; const int NT = seq / KVBLK;
  constexpr int SE = 0, SO = SDEPTH - 1;
  SLOAD(SE, 0); asm volatile("s_waitcnt vmcnt(0)" ::: "memory"); SWRITE(0, SE); __syncthreads();
  qkt(pA0, pA1, K_lds, qr, r32, hi); partialSM(pA0, pA1, m_reg, mnA, alA);
  SLOAD(SO, KVBLK); if constexpr (SDEPTH == 2) { if (2 < NT) SLOAD(SE, 2 * KVBLK); }
  SWAIT(); SWRITE(1, SO); __syncthreads();
  for (int j = 1; j + 1 < NT; j += 2) {
    SBAR(); qkt(pB0, pB1, (bf16*)((char*)K_lds + SHM_K), qr, r32, hi);
    finishSM(pA0, pA1, alA, l_reg, pa0, pa1, pa2, pa3); SBAR();
    SLOAD(SO, (j + SDEPTH) * KVBLK); SBAR();
    pv_d0(o, vb0, pa0, pa1, pa2, pa3); partialSM(pB0, pB1, m_reg, mnB, alB);
    __syncthreads(); SWAIT(); SWRITE(0, SE);
    RESC(alB); __syncthreads();
    SBAR(); qkt(pA0, pA1, K_lds, qr, r32, hi);
    finishSM(pB0, pB1, alB, l_reg, pa0, pa1, pa2, pa3); SBAR();
    if (SDEPTH == 1 || j + 3 < NT) SLOAD(SE, (j + 1 + SDEPTH) * KVBLK); SBAR();
    pv_d0(o, vb0 + (int)SHM_V, pa0, pa1, pa2, pa3); partialSM(pA0, pA1, m_reg, mnA, alA);
    __syncthreads(); SWAIT(); SWRITE(1, SO);
    RESC(alA); __syncthreads();
  }
  SBAR(); qkt(pB0, pB1, (bf16*)((char*)K_lds + SHM_K), qr, r32, hi);
  finishSM(pA0, pA1, alA, l_reg, pa0, pa1, pa2, pa3); SBAR();
  pv_d0(o, vb0, pa0, pa1, pa2, pa3); partialSM(pB0, pB1, m_reg, mnB, alB);
  __syncthreads(); RESC(alB);
  finishSM(pB0, pB1, alB, l_reg, pa0, pa1, pa2, pa3); SBAR();
  pv_d0(o, vb0 + (int)SHM_V, pa0, pa1, pa2, pa3);
  if (hi == 0) li_l[r32] = l_reg; asm volatile("s_waitcnt lgkmcnt(0)" ::: "memory");
  float rli[16];
#pragma unroll
  for (int r = 0; r < 16; ++r) rli[r] = __builtin_amdgcn_rcpf(li_l[crow(r, hi)]);
  bf16* Ow = Ob + (long)(wid * QBLK) * LDO;
#pragma unroll
  for (int r = 0; r < 16; ++r) { int orow = crow(r, hi);
    for (int d0 = 0; d0 < 4; ++d0) Ow[(long)orow * LDO + d0 * 32 + r32] = __float2bfloat16(o[d0][r] * rli[r]); }
#undef SLOAD
#undef SWRITE
#undef SWAIT
  __syncthreads();
}

__device__ __forceinline__ void attn_b_unit(const bf16* __restrict__ P, bf16* __restrict__ OBG, float* __restrict__ LSE, const float* btab, char* vlds, float* ws, int unit, int lane) {
  using St = Stage<bf16>;
  const int r32 = lane & 31, hi = lane >> 5;
  const int g = unit >> 10, rest = unit & 1023, b = rest >> 8, h = (rest >> 6) & 3, idx = rest & 63;
  const int dsh = 2 * g, d = 1 << dsh, rd = idx & (d - 1), qblk = idx >> dsh;
  const int kq = 32 * qblk + r32;
  const int tq = rd + (kq << dsh);
  float* li_l = ws; float* al_l = ws + 32;
  float m_reg = -1e30f, l_reg = 0; f32x16 o[4] = {};
  const int vb0 = (int)(uintptr_t)vlds + v_rd_base(lane);
  const int srow = lane >> 4, sc = (lane & 15) * 8;
  const bf16* Qp = P + (size_t)(b * SEQ + tq) * INW + C_QB + g * 512 + h * 128 + hi * 8;
  bf16x8 qr[8];
#pragma unroll
  for (int d0 = 0; d0 < 8; ++d0) qr[d0] = St::ld8(Qp + d0 * 16);
  const int L64 = (SEQ >> dsh) >> 6;
  int tlo = (32 * qblk - 64) >> 6, thi = (32 * qblk + 31 + 64) >> 6; tlo = tlo < 0 ? 0 : tlo; thi = thi > L64 - 1 ? L64 - 1 : thi;
  const size_t rstride = (size_t)d * INW;
  const bf16* Kb = P + (size_t)(b * SEQ + rd) * INW + C_KB + g * 512 + h * 128;
  const bf16* Vb = Kb + (C_VB - C_KB);
  const float* bt = btab + (g * 4 + h) * 129 + 64;
  for (int t = tlo; t <= thi; ++t) {
    const int k0 = t * 64;
    f32x16 p0 = {}, p1 = {};
    { const bf16* K0 = Kb + (size_t)(k0 + r32) * rstride + hi * 8; const bf16* K1 = K0 + 32 * rstride;
#pragma unroll
      for (int d0 = 0; d0 < 8; ++d0) { const bf16x8 b0 = St::ld8(K0 + d0 * 16), b1 = St::ld8(K1 + d0 * 16);
        p0 = __builtin_amdgcn_mfma_f32_32x32x16_bf16(b0, qr[d0], p0, 0, 0, 0);
        p1 = __builtin_amdgcn_mfma_f32_32x32x16_bf16(b1, qr[d0], p1, 0, 0, 0); } }
    { const bf16* V0 = Vb + (size_t)(k0 + srow) * rstride + sc;
#pragma unroll
      for (int it = 0; it < 16; ++it) { const bf16x8 v = St::ld8(V0 + (size_t)(4 * it) * rstride); *(bf16x8*)(vlds + v_st(4 * it + srow, sc)) = v; } }
#pragma unroll
    for (int r = 0; r < 16; ++r) { const int rel = k0 + crow(r, hi) - kq; const int rc = rel < -64 ? -64 : (rel > 64 ? 64 : rel);
      p0[r] = (rel == rc) ? p0[r] + bt[rc] : -1e30f; }
#pragma unroll
    for (int r = 0; r < 16; ++r) { const int rel = k0 + 32 + crow(r, hi) - kq; const int rc = rel < -64 ? -64 : (rel > 64 ? 64 : rel);
      p1[r] = (rel == rc) ? p1[r] + bt[rc] : -1e30f; }
    float mn, alpha; bf16x8 pa0, pa1, pa2, pa3;
    partialSM(p0, p1, m_reg, mn, alpha);
    RESC(alpha);
    finishSM(p0, p1, alpha, l_reg, pa0, pa1, pa2, pa3);
    asm volatile("s_waitcnt lgkmcnt(0)" ::: "memory"); SBAR();
    pv_d0(o, vb0, pa0, pa1, pa2, pa3);
  }
  if (hi == 0) { li_l[r32] = l_reg; LSE[((size_t)g * TOK + b * SEQ + tq) * 4 + h] = m_reg * SCALE + __logf(l_reg); }
  asm volatile("s_waitcnt lgkmcnt(0)" ::: "memory");
  float rli[16];
#pragma unroll
  for (int r = 0; r < 16; ++r) rli[r] = __builtin_amdgcn_rcpf(li_l[crow(r, hi)]);
#pragma unroll
  for (int r = 0; r < 16; ++r) { const int i = crow(r, hi); bf16* Ow = OBG + ((size_t)g * TOK + b * SEQ + rd + ((32 * qblk + i) << dsh)) * 512 + h * 128 + r32;
    for (int d0 = 0; d0 < 4; ++d0) Ow[d0 * 32] = __float2bfloat16(o[d0][r] * rli[r]); }
  asm volatile("s_waitcnt lgkmcnt(0)" ::: "memory");
}
#undef RESC
}
#define LAS __attribute__((address_space(3)))
typedef unsigned short bf16r;
typedef unsigned v4u __attribute__((ext_vector_type(4)));
typedef float v4f __attribute__((ext_vector_type(4)));
constexpr int NWAVES = 8, NTHREADS = 512;
constexpr int LDS_BYTES = 147456, RING_BYTES = 131072;
constexpr size_t MiB = 1u << 20;
constexpr size_t WS_SUMSQ = 0;
constexpr size_t WS_BTAB = 64 * 1024;
constexpr size_t WS_CTRS = 96 * 1024;
constexpr size_t WS_NORMW = 112 * 1024;
constexpr size_t WS_XBAR = 256 * 1024;
constexpr size_t WS_ROPE = 128 * 1024;
constexpr size_t WS_WIN = 1 * MiB;
constexpr size_t WS_WPA = WS_WIN + (size_t)INW * DM * 2;
constexpr size_t WS_WOUT = WS_WPA + (size_t)DM * 2560 * 2;
constexpr size_t WS_WGU = WS_WOUT + (size_t)DM * DM * 2;
constexpr size_t WS_WDN = WS_WGU + (size_t)NGU * DM * 2;
constexpr size_t WS_XN = WS_WDN + (size_t)DM * DFF * 2;
constexpr size_t WS_OA = WS_XN + (size_t)TOK * DM * 2;
constexpr size_t WS_OB = WS_OA + (size_t)TOK * 2560 * 2;
constexpr size_t WS_MG = WS_OB + (size_t)TOK * 512 * 2;
constexpr size_t WS_P = WS_MG + (size_t)TOK * DM * 2;
constexpr size_t WS_OBG = WS_P + (size_t)TOK * INW * 2;
constexpr size_t WS_LSE = WS_OBG + (size_t)3 * TOK * 512 * 2;
constexpr size_t WS_KVA = WS_LSE + (size_t)3 * TOK * 4 * 4;
constexpr size_t WS_END = WS_KVA + (size_t)BATCH * 8 * SEQ * 128 * 2;

__device__ __forceinline__ unsigned f2bf(float f) { unsigned u = __builtin_bit_cast(unsigned, f); return (u + 0x7fffu + ((u >> 16) & 1u)) >> 16; }
__device__ __forceinline__ unsigned pk2(float lo, float hi) { return f2bf(lo) | (f2bf(hi) << 16); }
__device__ __forceinline__ float wave_sum(float v) {
#pragma unroll
    for (int o = 1; o < 64; o <<= 1) v += __shfl_xor(v, o);
    return v;
}
struct CvtItem { const float* src; bf16r* dst; const float* kscale; int N, K, k0, n0, drow0, perm; };
__device__ __forceinline__ void cvt_load(const CvtItem& c, v4f (&r)[16], int lane) {
    const int lr = lane >> 4, lc = (lane & 15) * 4; const float* p = c.src + (size_t)(c.k0 + lr) * c.N + c.n0 + lc;
#pragma unroll
    for (int i = 0; i < 16; ++i) r[i] = *(const v4f*)(p + (size_t)(4 * i) * c.N);
}
__device__ __forceinline__ void cvt_process(const CvtItem& c, v4f (&r)[16], LAS float* scr, int lane) {
    const int lr = lane >> 4, lc = (lane & 15) * 4;
#pragma unroll
    for (int i = 0; i < 16; ++i) { const int kk = 4 * i + lr; v4f v = r[i];
        if (c.kscale) { const float sc = c.kscale[c.k0 + kk]; v = v * sc; }
        LAS float* d = scr + kk * 65 + lc; d[0] = v[0]; d[1] = v[1]; d[2] = v[2]; d[3] = v[3]; }
    asm volatile("s_waitcnt lgkmcnt(0)" ::: "memory");
    const int cc = lane & 7;
#pragma unroll
    for (int j = 0; j < 8; ++j) { const int n = (lane >> 3) + 8 * j; const LAS float* sp = scr + (8 * cc) * 65 + n;
        v4u o; o.x = pg8::cvt_pk_bf16(sp[0 * 65], sp[1 * 65]); o.y = pg8::cvt_pk_bf16(sp[2 * 65], sp[3 * 65]); o.z = pg8::cvt_pk_bf16(sp[4 * 65], sp[5 * 65]); o.w = pg8::cvt_pk_bf16(sp[6 * 65], sp[7 * 65]);
        const int nd = c.perm ? (((n & 31) >> 2) * 8 + (n >> 5) * 4 + (n & 3)) : n;
        *(v4u*)(c.dst + (size_t)(c.drow0 + nd) * c.K + c.k0 + 8 * cc) = o; }
    asm volatile("s_waitcnt lgkmcnt(0)" ::: "memory");
}
template <class Decode, class Next>
__device__ __forceinline__ void cvt_run(const Decode& dec, Next& next, LAS float* scr, int lane) {
    v4f ra[16], rb[16]; CvtItem ia, ib;
    int ida = next(); if (ida < 0) return;
    ia = dec(ida); cvt_load(ia, ra, lane);
    for (;;) {
        const int idb = next(); if (idb >= 0) { ib = dec(idb); cvt_load(ib, rb, lane); }
        cvt_process(ia, ra, scr, lane);
        if (idb < 0) break;
        ida = next(); if (ida >= 0) { ia = dec(ida); cvt_load(ia, ra, lane); }
        cvt_process(ib, rb, scr, lane);
        if (ida < 0) break;
    }
}
struct NextStatic { int cur, step, total; __device__ __forceinline__ int operator()() { const int v = cur; cur += step; return v < total ? v : -1; } };
struct NextQueue { unsigned* ctr; int total, lane; int cur = 0, end = 0; static constexpr int CH = 8;
    __device__ __forceinline__ int operator()() { if (cur >= end) { unsigned v = 0; if (lane == 0) v = atomicAdd(ctr, (unsigned)CH); v = __builtin_amdgcn_readfirstlane(v); if (v >= (unsigned)total) return -1; cur = (int)v; end = cur + CH < total ? cur + CH : total; } return cur++; } };

#define XB_TMO      128
#define XB_XCNT(j)  (256  + 64 * (j))
#define XB_XSUB(j)  (1280 + 64 * (j))
#define XB_XGEN(j)  (2304 + 64 * (j))
#define XB_TOP      3328
#define XB_TOPGEN   3392
#define XCD_BAR_WORDS 3456
#define XB_SPIN_CAP (1u << 18)

__device__ __forceinline__ unsigned xb_ld(unsigned* p)              { return __hip_atomic_load(p, __ATOMIC_RELAXED, __HIP_MEMORY_SCOPE_AGENT); }
__device__ __forceinline__ unsigned xb_add(unsigned* p, unsigned v) { return __hip_atomic_fetch_add(p, v, __ATOMIC_RELAXED, __HIP_MEMORY_SCOPE_AGENT); }
__device__ __forceinline__ unsigned xb_xcc_id() { return (unsigned)__builtin_amdgcn_s_getreg((3 << 11) | 20) & 0xFu; }
#define XB_SPIN(cond, bar) do { unsigned _sp = 0; while (cond) { __builtin_amdgcn_s_sleep(1); \
    if ((++_sp & 255u) == 0u) { if (xb_ld(&(bar)[XB_TMO])) break; if (_sp > XB_SPIN_CAP) { atomicAdd(&(bar)[XB_TMO], 1u); break; } } } } while (0)

struct XcdBarrier {
    unsigned* bar; unsigned x;
    volatile LAS unsigned* st;
};

__device__ __forceinline__ XcdBarrier xcd_barrier_post(unsigned* bar, volatile LAS unsigned* st) {
    XcdBarrier b; b.bar = bar; b.x = xb_xcc_id(); b.st = st;
    if (threadIdx.x == 0) (void)xb_add(&bar[XB_XCNT(b.x)], 1u);
    return b;
}
__device__ __forceinline__ void xcd_barrier_complete(unsigned* bar, unsigned x, unsigned& nloc, unsigned& nx) {
    const unsigned G = gridDim.x * gridDim.y * gridDim.z;
    unsigned sum, cnt, mine, sp = 0u;
    for (;;) {
        sum = 0u; cnt = 0u; mine = 0u;
#pragma unroll
        for (unsigned j = 0; j < 16; ++j) { const unsigned c = xb_ld(&bar[XB_XCNT(j)]); sum += c; cnt += (c > 0u) ? 1u : 0u; mine = (j == x) ? c : mine; }
        if (sum == G) break;
        __builtin_amdgcn_s_sleep(1);
        if ((++sp & 255u) == 0u) { if (xb_ld(&bar[XB_TMO])) break; if (sp > XB_SPIN_CAP) { atomicAdd(&bar[XB_TMO], 1u); break; } }
    }
    nloc = mine > 0u ? mine : 1u; nx = cnt > 0u ? cnt : 1u;
}

__device__ __forceinline__ void xcd_barrier(const XcdBarrier& b) {
    asm volatile("s_waitcnt vmcnt(0)" ::: "memory");
    __syncthreads();
    if (threadIdx.x == 0) {
        unsigned* bar = b.bar;
        __builtin_amdgcn_s_waitcnt(0);
        unsigned nloc = b.st[0], nx = b.st[1];
        if (nloc == 0u) { xcd_barrier_complete(bar, b.x, nloc, nx); b.st[0] = nloc; b.st[1] = nx; }
        const unsigned old = xb_add(&bar[XB_XSUB(b.x)], 1u);
        const unsigned gen = old / nloc;
        if (old + 1u == (gen + 1u) * nloc) {
            __builtin_amdgcn_fence(__ATOMIC_RELEASE, "agent");
            asm volatile("s_waitcnt vmcnt(0)" ::: "memory");
            const unsigned og = xb_add(&bar[XB_TOP], 1u);
            const unsigned tg = og / nx;
            if (og + 1u == (tg + 1u) * nx) xb_add(&bar[XB_TOPGEN], 1u);
            else XB_SPIN(xb_ld(&bar[XB_TOPGEN]) == tg, bar);
            __builtin_amdgcn_fence(__ATOMIC_ACQUIRE, "agent");
            xb_add(&bar[XB_XGEN(b.x)], 1u);
            asm volatile("s_waitcnt vmcnt(0)" ::: "memory");
        } else {
            XB_SPIN(xb_ld(&bar[XB_XGEN(b.x)]) == gen, bar);
            __builtin_amdgcn_fence(__ATOMIC_ACQUIRE, "agent");
            asm volatile("s_waitcnt vmcnt(0)" ::: "memory");
        }
    }
    __syncthreads();
}


struct DecPlain { const float* w; bf16r* d; int N, K, perm_below;
    __device__ __forceinline__ CvtItem operator()(int r) const { CvtItem c; const int nb = N / 64, kb = r / nb, n0 = (r % nb) * 64; c.src = w; c.dst = d; c.kscale = nullptr; c.N = N; c.K = K; c.k0 = kb * 64; c.n0 = n0; c.drow0 = n0; c.perm = n0 < perm_below; return c; } };
struct DecGU { const float *wg, *wu, *n2; bf16r* d;
    static constexpr int I_G = 64 * (DFF / 64);
    __device__ __forceinline__ CvtItem operator()(int r) const { CvtItem c; const int which = r >= I_G; if (which) r -= I_G; const int nb = DFF / 64, kb = r / nb, n0 = (r % nb) * 64;
        c.src = which ? wu : wg; c.dst = d; c.kscale = n2; c.N = DFF; c.K = DM; c.k0 = kb * 64; c.n0 = n0; c.drow0 = (n0 >> 7) * 256 + which * 128 + (n0 & 127); c.perm = 0; return c; } };

struct Args { const float* in[16]; float* out; unsigned char* ws; };

__global__ void __launch_bounds__(NTHREADS) fwd_megakernel(Args a) {
    extern __shared__ __attribute__((aligned(16))) unsigned char lds[];
    cg::grid_group grid = cg::this_grid();
#define PH_BEGIN() unsigned char* wsl = a.ws; asm volatile("" : "+s"(wsl)); const int wave = wave_s; int lane; asm volatile("v_mbcnt_lo_u32_b32 %0, -1, 0\n\tv_mbcnt_hi_u32_b32 %0, -1, %0" : "=v"(lane)); const int tid = wave * 64 + lane; \
    const int G = gridDim.x, gw = blockIdx.x * NWAVES + wave, NGW = G * NWAVES; \
    (void)lane; (void)gw; (void)NGW; (void)wsl
#define A_x        (a.in[0])
#define A_norm1_g  (a.in[1])
#define A_w_in     (a.in[2])
#define A_b_gate   (a.in[3])
#define A_q_norm_a (a.in[4])
#define A_k_norm_a (a.in[5])
#define A_q_norm_b (a.in[6])
#define A_k_norm_b (a.in[7])
#define A_rel_bias (a.in[8])
#define A_w_pa     (a.in[9])
#define A_w_pb     (a.in[10])
#define A_w_out    (a.in[11])
#define A_norm2_g  (a.in[12])
#define A_w_gate   (a.in[13])
#define A_w_up     (a.in[14])
#define A_w_down   (a.in[15])
#define A_out      (a.out)
#define SUMSQ ((float*)(wsl + WS_SUMSQ))
#define BTAB  ((float*)(wsl + WS_BTAB))
#define CTRS  ((unsigned*)(wsl + WS_CTRS))
#define XBAR  ((unsigned*)(wsl + WS_XBAR))
#define NORMW ((float*)(wsl + WS_NORMW))
#define ROPE  ((float*)(wsl + WS_ROPE))
#define WIN   ((bf16r*)(wsl + WS_WIN))
#define WPA   ((bf16r*)(wsl + WS_WPA))
#define WPB   ((bf16r*)(wsl + WS_WPA) + 2048)
#define WOUT  ((bf16r*)(wsl + WS_WOUT))
#define WGU   ((bf16r*)(wsl + WS_WGU))
#define WDN   ((bf16r*)(wsl + WS_WDN))
#define XN    ((bf16r*)(wsl + WS_XN))
#define OA    ((bf16r*)(wsl + WS_OA))
#define OB    ((bf16r*)(wsl + WS_OB))
#define MG    ((bf16r*)(wsl + WS_MG))
#define OBG   ((bf16r*)(wsl + WS_OBG))
#define LSE   ((float*)(wsl + WS_LSE))
#define KVA   ((bf16r*)(wsl + WS_KVA))
#define A_P     ((bf16r*)(wsl + WS_P))
#define ACT   ((bf16r*)(wsl + WS_P))
    PG8_LAS unsigned char* ring = (PG8_LAS unsigned char*)lds;
    const int wave_s = __builtin_amdgcn_readfirstlane(threadIdx.x >> 6);

    { PH_BEGIN();
        const int gt = blockIdx.x * NTHREADS + tid, NGT = G * NTHREADS;
        for (int i = gt; i < TOK; i += NGT) SUMSQ[i] = 0.f;
        for (int i = gt; i < 3456; i += NGT) XBAR[i] = 0u;
        if (tid < 4) ((LAS unsigned*)(lds + LDS_BYTES - 16))[tid] = 0u;
        for (int i = gt; i < 12 * 129; i += NGT) {
            const int hh = i / 129, jj = i % 129, g = hh >> 2, d = 1 << (2 * g), rel = (jj - 64) * d;
            const int n = rel < 0 ? -rel : rel; const int side = rel > 0 ? 16 : 0;
            const float nf = (float)(n < 1 ? 1 : n);
            int large = 8 + (int)(logf(nf / 8.f) / 4.852030263919617f * 8.f); large = large > 15 ? 15 : large;
            const int bucket = side + (n < 8 ? n : large);
            BTAB[i] = A_rel_bias[bucket * 12 + hh] * (1.0f / att::SCALE);
        }
        for (int i = gt; i < 64 * 32; i += NGT) {
            const int pos = i >> 5, j = i & 31; const float inv = powf(10000.f, -(float)(2 * j) / 64.f); const float ang = (float)pos * inv;
            ROPE[2 * i] = cosf(ang); ROPE[2 * i + 1] = sinf(ang);
        }
        if (gt < 128) { CTRS[gt] = 0u; NORMW[gt] = A_q_norm_a[gt]; NORMW[128 + gt] = A_k_norm_a[gt]; NORMW[256 + gt] = A_q_norm_b[gt]; NORMW[384 + gt] = A_k_norm_b[gt]; }
        LAS float* scr = (LAS float*)(lds) + wave * (64 * 65);
        { DecPlain dec{A_w_in, WIN, INW, DM, C_VA}; NextStatic nx{gw, NGW, 64 * (INW / 64)}; cvt_run(dec, nx, scr, lane); }

        for (int m = gw; m < TOK; m += NGW) {
            const v4f* xr = (const v4f*)(A_x + (size_t)m * DM) + lane; v4f v[16]; float s = 0.f;
#pragma unroll
            for (int j = 0; j < 16; ++j) { v[j] = xr[64 * j]; s += (v[j][0] * v[j][0] + v[j][1] * v[j][1]) + (v[j][2] * v[j][2] + v[j][3] * v[j][3]); }
            const float rstd = 1.0f / sqrtf(wave_sum(s) * (1.0f / DM) + EPS);
            unsigned long long* o8 = (unsigned long long*)(XN + (size_t)m * DM) + lane;
#pragma unroll
            for (int j = 0; j < 16; ++j) { const v4f g = ((const v4f*)A_norm1_g)[lane + 64 * j];
                o8[64 * j] = (unsigned long long)pk2(v[j][0] * rstd * g[0], v[j][1] * rstd * g[1]) | ((unsigned long long)pk2(v[j][2] * rstd * g[2], v[j][3] * rstd * g[3]) << 32); }
        }
    }
    grid.sync();
    const XcdBarrier xbar = xcd_barrier_post((unsigned*)(a.ws + WS_XBAR), (volatile LAS unsigned*)(lds + LDS_BYTES - 16));

    { PH_BEGIN();
        const int NG1 = G;
        if ((int)blockIdx.x < NG1) {
            pg8::Gemm g{XN, WIN, TOK, INW, DM}; pg8::StaticOrder S; S.init(TOK, INW, NG1, (int)blockIdx.x);
            pg8::EpiIn E{A_P, KVA, A_b_gate, NORMW, ROPE, (PG8_LAS float*)(ring + RING_BYTES)};
            pg8::gemm_phase<pg8::EpiIn, pg8::StaticOrder, true, true>(ring, g, S, E, tid);
        }
        { LAS float* scr = (LAS float*)(lds) + wave * (64 * 65);
          { DecPlain dec{A_w_out, WOUT, DM, DM, 0}; NextQueue nx{CTRS + 16, 64 * 64, lane}; cvt_run(dec, nx, scr, lane); }
          { DecPlain dec{A_w_pa, WPA, DM, 2560, 0}; NextQueue nx{CTRS + 32, 32 * 64, lane}; cvt_run(dec, nx, scr, lane); }
          { DecPlain dec{A_w_pb, WPB, DM, 2560, 0}; NextQueue nx{CTRS + 48, 8 * 64, lane}; cvt_run(dec, nx, scr, lane); }
          { DecGU dec{A_w_gate, A_w_up, A_norm2_g, WGU}; NextQueue nx{CTRS + 0, 2 * DecGU::I_G, lane}; cvt_run(dec, nx, scr, lane); } }
    }
    xcd_barrier(xbar);

    { PH_BEGIN();
        for (int u = blockIdx.x; u < BATCH * 16 * 8; u += G) {
            const int qb = u & 7, h = (u >> 3) & 15, b = u >> 7, kvh = h >> 2;
            const att::bf16* Pb = (const att::bf16*)A_P + (size_t)(b * SEQ) * INW;
            const att::bf16* Kc = (const att::bf16*)KVA + ((size_t)(b * 8 + kvh) * SEQ) * 128; const att::bf16* Vc = Kc + (size_t)4 * SEQ * 128;
            att::attn_dense_body<INW, 128, 2560>(Pb + (size_t)(qb * 256) * INW + C_QA + h * 128, Kc, Vc,
                                                 (att::bf16*)OA + (size_t)(b * SEQ + qb * 256) * 2560 + h * 128, SEQ, (char*)lds, tid);
        }
        float* btab = (float*)(lds + RING_BYTES + 2048);
        for (int i = tid; i < 12 * 129; i += NTHREADS) btab[i] = BTAB[i];
        __syncthreads();
        for (int u = gw; u < 3072; u += NGW)
            att::attn_b_unit((const att::bf16*)A_P, (att::bf16*)OBG, LSE, btab, (char*)lds + wave * 16384, (float*)(lds + RING_BYTES) + wave * 64, u, lane);
    }
    xcd_barrier(xbar);

    { PH_BEGIN();
        pg8::StaticOrder S; S.init(TOK, DM, G, (int)blockIdx.x);
        {
            int done_pm = -1;
            for (int ui = 0; ; ++ui) { pg8::Unit uu; if (!S.next(ui, uu)) break; if (uu.pm == done_pm) continue; done_pm = uu.pm;
                const int ch = tid & 63, hh = ch >> 4;
                for (int it0 = 0; it0 < 32; it0 += 8) {
                    float l[8][3]; v4u av[8][3];
#pragma unroll
                    for (int j = 0; j < 8; ++j) { const int row = uu.pm * 256 + (it0 + j) * 8 + (tid >> 6);
#pragma unroll
                        for (int g = 0; g < 3; ++g) { l[j][g] = LSE[((size_t)g * TOK + row) * 4 + hh]; av[j][g] = *(const v4u*)(OBG + ((size_t)g * TOK + row) * 512 + ch * 8); } }
#pragma unroll
                    for (int j = 0; j < 8; ++j) { const int row = uu.pm * 256 + (it0 + j) * 8 + (tid >> 6);
                        const float mx = fmaxf(l[j][0], fmaxf(l[j][1], l[j][2])); float w0 = __expf(l[j][0] - mx), w1 = __expf(l[j][1] - mx), w2 = __expf(l[j][2] - mx); const float inv = 1.0f / (w0 + w1 + w2); w0 *= inv; w1 *= inv; w2 *= inv;
                        pg8::f32x4 x0, x1, y0, y1, z0, z1; pg8::unpack8(av[j][0], x0, x1); pg8::unpack8(av[j][1], y0, y1); pg8::unpack8(av[j][2], z0, z1);
                        *(v4u*)(OA + (size_t)row * 2560 + 2048 + ch * 8) = pg8::pack8(x0 * w0 + y0 * w1 + z0 * w2, x1 * w0 + y1 * w1 + z1 * w2); } } }
            asm volatile("s_waitcnt vmcnt(0)" ::: "memory"); __syncthreads();
        }
        { pg8::Gemm g{OA, WPA, TOK, DM, 2560}; pg8::EpiMerge E{A_P, MG, 32}; pg8::gemm_phase<pg8::EpiMerge, pg8::StaticOrder, true, true>(ring, g, S, E, tid); }
    }
    xcd_barrier(xbar);

    { PH_BEGIN();
        pg8::Gemm g{MG, WOUT, TOK, DM, DM}; pg8::StaticOrder S; S.init(TOK, DM, G, (int)blockIdx.x);
        pg8::EpiOut E{A_x, A_out, XN, SUMSQ};
        pg8::gemm_phase<pg8::EpiOut, pg8::StaticOrder, true, true>(ring, g, S, E, tid);
    }
    xcd_barrier(xbar);

    { PH_BEGIN();
        const int NG6 = G;
        if ((int)blockIdx.x < NG6) {
            pg8::Gemm g{XN, WGU, TOK, NGU, DM}; pg8::StaticOrder S; S.init(TOK, NGU, NG6, (int)blockIdx.x);
            pg8::EpiGU E{SUMSQ, ACT};
            pg8::gemm_phase<pg8::EpiGU, pg8::StaticOrder, true, true>(ring, g, S, E, tid);
        }
        { LAS float* scr = (LAS float*)(lds) + wave * (64 * 65);
          { DecPlain dec{A_w_down, WDN, DM, DFF, 0}; NextQueue nx{CTRS + 64, (DFF / 64) * 64, lane}; cvt_run(dec, nx, scr, lane); } }

    }
    xcd_barrier(xbar);

    { PH_BEGIN();
        pg8::Gemm g{ACT, WDN, TOK, DM, DFF}; pg8::StaticOrder S; S.init(TOK, DM, G, (int)blockIdx.x);
        pg8::EpiDown E{XN, A_out};
        pg8::gemm_phase<pg8::EpiDown, pg8::StaticOrder, true, true>(ring, g, S, E, tid);
    }
}

extern "C" void kernel_launch(void* const* d_in, const int* in_sizes, int n_in, void* d_out, int out_size, void* d_ws, size_t ws_size, hipStream_t stream) {
    static int grid_blocks = 0;
    if (grid_blocks == 0) {
        if (n_in != 16 || in_sizes[0] != TOK * DM || out_size != TOK * DM || ws_size < WS_END) {
            fprintf(stderr, "kernel_launch: unexpected shapes (n_in %d, in0 %d, out %d, ws %zu, need %zu); nothing launched\n", n_in, n_in > 0 ? in_sizes[0] : -1, out_size, ws_size, (size_t)WS_END); grid_blocks = -1; return; }
        int dev = 0, cus = 0, per_cu = 0;
        hipGetDevice(&dev); hipDeviceGetAttribute(&cus, hipDeviceAttributeMultiprocessorCount, dev);
        if (hipFuncSetAttribute((const void*)fwd_megakernel, hipFuncAttributeMaxDynamicSharedMemorySize, LDS_BYTES) != hipSuccess) { fprintf(stderr, "kernel_launch: hipFuncSetAttribute failed\n"); grid_blocks = -1; return; }
        if (hipOccupancyMaxActiveBlocksPerMultiprocessor(&per_cu, (const void*)fwd_megakernel, NTHREADS, LDS_BYTES) != hipSuccess || per_cu < 1) { fprintf(stderr, "kernel_launch: occupancy query gave %d\n", per_cu); per_cu = 1; (void)hipGetLastError(); }
        grid_blocks = cus * per_cu;
    }
    if (grid_blocks < 0) return;
    Args a{};
    for (int i = 0; i < 16; ++i) a.in[i] = (const float*)d_in[i];
    a.out = (float*)d_out; a.ws = (unsigned char*)d_ws;
    void* args[] = {&a};
    hipError_t e = hipLaunchCooperativeKernel((const void*)fwd_megakernel, dim3(grid_blocks), dim3(NTHREADS), args, LDS_BYTES, stream);
    if (e != hipSuccess) fprintf(stderr, "cooperative launch failed: %s (grid %d)\n", hipGetErrorString(e), grid_blocks);
}
```

```cpp
#include <hip/hip_runtime.h>
#include <hip/hip_cooperative_groups.h>
#include <hip/hip_bf16.h>
#include <cstdio>
#include <cstdint>
namespace cg = cooperative_groups;

constexpr int BATCH = 4, SEQ = 2048, TOK = BATCH * SEQ, DM = 4096, INW = 15872, DFF = 11008, NGU = 2 * DFF;
constexpr int C_QA = 0, C_KA = 2048, C_VA = 2560, C_QB = 3072, C_KB = 4608, C_VB = 6144, C_GA = 7680, C_GB = 11776;
constexpr float EPS = 1e-6f;

namespace pg8 {
#define PG8_LAS __attribute__((address_space(3)))
typedef unsigned short bf16_t;
typedef short bf16x8 __attribute__((ext_vector_type(8)));
typedef float f32x4 __attribute__((ext_vector_type(4)));
typedef unsigned u32x4 __attribute__((ext_vector_type(4)));
constexpr int BM = 256, BK = 64, HALF = 128, HTB = HALF * BK * 2  , STAGE_BYTES = 8 * HTB, NXCD = 8, WGM = 8;

__host__ __device__ __forceinline__ int lds_byte(int r, int c) { const int st = (r >> 4) * 2 + (c >> 5), rr = r & 15, cc = c & 31, ob = rr * 64 + cc * 2; return st * 1024 + (ob ^ (((ob >> 9) & 1) << 5)); }
__host__ __device__ __forceinline__ void stage_rc(int b, int& R, int& C) { const int st = b / 1024, sb = b % 1024, swz = sb ^ (((sb >> 9) & 1) << 5); R = (st >> 1) * 16 + swz / 64; C = (st & 1) * 32 + (swz % 64) / 2; }
__host__ __device__ __forceinline__ int perm32(int rho) { const int n = rho >> 4, i = rho & 15; return 8 * (i >> 2) + 4 * n + (i & 3); }

struct Unit { int pm, pn; };
struct Gemm { const bf16_t* A; const bf16_t* Bt; int M, N, K; };

struct StaticOrder {
    int nM, nN, nwg, G, c;
    __host__ __device__ void init(int M, int N, int G_, int c_) { nM = M / BM; nN = N / BM; nwg = nM * nN; G = G_; c = c_; }
    __host__ __device__ bool next(int i, Unit& u) const {
        const long L = (long)i * G + c; if (L >= nwg) return false;
        int wgid = (int)L; { const int q = nwg / NXCD, r = nwg % NXCD, xcd = wgid % NXCD, off = wgid / NXCD; wgid = (xcd < r ? xcd * (q + 1) : r * (q + 1) + (xcd - r) * q) + off; }
        const int nig = WGM * nN, gid = wgid / nig, fm = gid * WGM, gsz = (nM - fm) < WGM ? (nM - fm) : WGM;
        u.pm = fm + ((wgid % nig) % gsz); u.pn = (wgid % nig) / gsz; return true;
    }
    __device__ __forceinline__ void a_ready(const Unit&) const {}
    __device__ __forceinline__ void done(const Unit&) const {}
};

__device__ __forceinline__ unsigned cvt_pk_bf16(float lo, float hi) { unsigned r; asm volatile("v_cvt_pk_bf16_f32 %0, %1, %2" : "=v"(r) : "v"(lo), "v"(hi)); return r; }
__device__ __forceinline__ float sigmoidf_(float x) { return __builtin_amdgcn_rcpf(1.f + __expf(-x)); }
__device__ __forceinline__ float bf_lo(unsigned w) { return __uint_as_float(w << 16); }
__device__ __forceinline__ float bf_hi(unsigned w) { return __uint_as_float(w & 0xffff0000u); }
__device__ __forceinline__ u32x4 pack8(const f32x4 v0, const f32x4 v1) { u32x4 w; w.x = cvt_pk_bf16(v0[0], v0[1]); w.y = cvt_pk_bf16(v0[2], v0[3]); w.z = cvt_pk_bf16(v1[0], v1[1]); w.w = cvt_pk_bf16(v1[2], v1[3]); return w; }
__device__ __forceinline__ void unpack8(const u32x4 w, f32x4& v0, f32x4& v1) { v0 = (f32x4){bf_lo(w.x), bf_hi(w.x), bf_lo(w.y), bf_hi(w.y)}; v1 = (f32x4){bf_lo(w.z), bf_hi(w.z), bf_lo(w.w), bf_hi(w.w)}; }

struct EpiIn {
    static constexpr bool PERM = true, AFTER_DRAIN = false, HOOK = false;
    bf16_t* O; bf16_t* KVA; const float* bgate; const float *normw, *rope; PG8_LAS float* part;
    __device__ __forceinline__ void operator()(const f32x4 (&acc)[2][2][4][2], const Unit& u, int wr, int wc, int fr, int fq) const {
        const int row0 = u.pm * BM + wr * 64 + fr, col0 = u.pn * BM + wc * 32 + 8 * fq;
        const int pn = u.pn;
        const bool gate = (pn >= 30), normed = (pn < 10) || (pn >= 12 && pn < 24), ahead = pn < 10;
        if (normed) {
#pragma unroll
            for (int ai = 0; ai < 2; ++ai)
#pragma unroll
                for (int m = 0; m < 4; ++m)
#pragma unroll
                    for (int bj = 0; bj < 2; ++bj) { const f32x4 v0 = acc[ai][bj][m][0], v1 = acc[ai][bj][m][1];
                        float ss = (v0[0] * v0[0] + v0[1] * v0[1]) + (v0[2] * v0[2] + v0[3] * v0[3]) + (v1[0] * v1[0] + v1[1] * v1[1]) + (v1[2] * v1[2] + v1[3] * v1[3]);
                        ss += __shfl_xor(ss, 16); ss += __shfl_xor(ss, 32);
                        if (fq == 0) part[(ai * HALF + wr * 64 + m * 16 + fr) * 8 + bj * 4 + wc] = ss; }
            asm volatile("s_waitcnt lgkmcnt(0)" ::: "memory"); __builtin_amdgcn_s_barrier(); asm volatile("" ::: "memory");
            const float* wn = normw + (pn < 8 ? 0 : (pn < 10 ? 128 : (pn < 18 ? 256 : 384)));
            const int half = wc >> 1, qq = (wc & 1) * 4 + fq;
            const f32x4 w0 = ahead ? *(const f32x4*)(wn + half * 64 + 4 * qq) : *(const f32x4*)(wn + wc * 32 + 8 * fq);
            const f32x4 w1 = ahead ? *(const f32x4*)(wn + half * 64 + 32 + 4 * qq) : *(const f32x4*)(wn + wc * 32 + 8 * fq + 4);
#pragma unroll
            for (int ai = 0; ai < 2; ++ai)
#pragma unroll
                for (int m = 0; m < 4; ++m) { const int rl = ai * HALF + wr * 64 + m * 16 + fr, row = u.pm * BM + rl; bf16_t* rowp = O + (size_t)row * INW + col0;
                    f32x4 cs0 = {1.f, 0.f, 1.f, 0.f}, cs1 = {1.f, 0.f, 1.f, 0.f};
                    if (ahead) { const int t = row & (SEQ - 1), pos = half ? (t & 63) : (t >> 6); const float* rt = rope + ((size_t)pos * 32 + 4 * qq) * 2; cs0 = *(const f32x4*)rt; cs1 = *(const f32x4*)(rt + 4); }
#pragma unroll
                    for (int bj = 0; bj < 2; ++bj) { const f32x4 p4 = *(const PG8_LAS f32x4*)(part + rl * 8 + bj * 4);
                        const float rstd = __builtin_amdgcn_rsqf(((p4[0] + p4[1]) + (p4[2] + p4[3])) * (1.0f / 128.f) + EPS);
                        f32x4 v0 = acc[ai][bj][m][0] * rstd * w0, v1 = acc[ai][bj][m][1] * rstd * w1;
                        if (ahead) { const f32x4 c = {cs0[0], cs0[2], cs1[0], cs1[2]}, sn = {cs0[1], cs0[3], cs1[1], cs1[3]};
                            const f32x4 lo = v0 * c - v1 * sn, hi = v1 * c + v0 * sn; v0 = lo; v1 = hi; }
                        bf16_t* dst = (pn >= 8 && pn < 12) ? KVA + (((size_t)(row >> 11) * 8 + (pn - 8) * 2 + bj) * SEQ + (row & (SEQ - 1))) * 128 + wc * 32 + 8 * fq : rowp + bj * HALF;
                        *(u32x4*)dst = pack8(v0, v1); } }
            return;
        }
        f32x4 bv[2][2];
#pragma unroll
        for (int bj = 0; bj < 2; ++bj)
#pragma unroll
            for (int n = 0; n < 2; ++n) bv[bj][n] = gate ? *(const f32x4*)(bgate + (col0 - C_GA) + bj * HALF + 4 * n) : (f32x4){0.f, 0.f, 0.f, 0.f};
#pragma unroll
        for (int ai = 0; ai < 2; ++ai)
#pragma unroll
            for (int m = 0; m < 4; ++m) { const int row = row0 + ai * HALF + m * 16; bf16_t* rowp = O + (size_t)row * INW + col0;
#pragma unroll
                for (int bj = 0; bj < 2; ++bj) { f32x4 v0 = acc[ai][bj][m][0], v1 = acc[ai][bj][m][1];
                    if (gate) { v0 += bv[bj][0]; v1 += bv[bj][1];
#pragma unroll
                        for (int e = 0; e < 4; ++e) { v0[e] = sigmoidf_(v0[e]); v1[e] = sigmoidf_(v1[e]); } }
                    bf16_t* dst = (pn >= 8 && pn < 12) ? KVA + (((size_t)(row >> 11) * 8 + (pn - 8) * 2 + bj) * SEQ + (row & (SEQ - 1))) * 128 + wc * 32 + 8 * fq : rowp + bj * HALF;
                    *(u32x4*)dst = pack8(v0, v1); } }
    }
};
struct EpiMerge {
    static constexpr bool PERM = true, AFTER_DRAIN = false, HOOK = true;
    const bf16_t* P; bf16_t* MG; int hook_t;
    __device__ __forceinline__ void hook(f32x4 (&acc)[2][2][4][2], const Unit& u, int wr, int wc, int fr, int fq) const {
        int row0 = u.pm * BM + wr * 64 + fr, col0 = u.pn * BM + wc * 32 + 8 * fq;
        asm volatile("" : "+v"(row0), "+v"(col0));
#pragma unroll
        for (int ai = 0; ai < 2; ++ai)
#pragma unroll
            for (int m = 0; m < 4; ++m) { const size_t row = (size_t)(row0 + ai * HALF + m * 16);
#pragma unroll
                for (int bj = 0; bj < 2; ++bj) { const int col = col0 + bj * HALF;
                    f32x4 a0, a1, b0, b1; unpack8(*(const u32x4*)(P + row * INW + C_GA + col), a0, a1); unpack8(*(const u32x4*)(P + row * INW + C_GB + col), b0, b1);
#pragma unroll
                    for (int e = 0; e < 4; ++e) { acc[ai][bj][m][0][e] *= a0[e] * __builtin_amdgcn_rcpf(fmaxf(b0[e], 1e-30f)); acc[ai][bj][m][1][e] *= a1[e] * __builtin_amdgcn_rcpf(fmaxf(b1[e], 1e-30f)); }
                    asm volatile("" ::: "memory"); } }
    }
    __device__ __forceinline__ void operator()(const f32x4 (&acc)[2][2][4][2], const Unit& u, int wr, int wc, int fr, int fq) const {
        const int row0 = u.pm * BM + wr * 64 + fr, col0 = u.pn * BM + wc * 32 + 8 * fq;
#pragma unroll
        for (int ai = 0; ai < 2; ++ai)
#pragma unroll
            for (int m = 0; m < 4; ++m) { const size_t row = (size_t)(row0 + ai * HALF + m * 16);
#pragma unroll
                for (int bj = 0; bj < 2; ++bj) { const int col = col0 + bj * HALF;
                    f32x4 g0, g1; unpack8(*(const u32x4*)(P + row * INW + C_GB + col), g0, g1);
                    *(u32x4*)(MG + row * DM + col) = pack8(acc[ai][bj][m][0] * g0, acc[ai][bj][m][1] * g1); } }
    }
};
struct EpiOut {
    static constexpr bool PERM = true, AFTER_DRAIN = false, HOOK = false;
    const float* x; float* out; bf16_t* XB; float* sumsq;
    __device__ __forceinline__ void operator()(const f32x4 (&acc)[2][2][4][2], const Unit& u, int wr, int wc, int fr, int fq) const {
        const int row0 = u.pm * BM + wr * 64 + fr, col0 = u.pn * BM + wc * 32 + 8 * fq;
#pragma unroll
        for (int ai = 0; ai < 2; ++ai)
#pragma unroll
            for (int m = 0; m < 4; ++m) { const size_t row = (size_t)(row0 + ai * HALF + m * 16); float ss = 0.f;
#pragma unroll
                for (int bj = 0; bj < 2; ++bj) { const int col = col0 + bj * HALF;
                    const f32x4 v0 = acc[ai][bj][m][0] + *(const f32x4*)(x + row * DM + col), v1 = acc[ai][bj][m][1] + *(const f32x4*)(x + row * DM + col + 4);
                    *(u32x4*)(XB + row * DM + col) = pack8(v0, v1);
                    ss += (v0[0] * v0[0] + v0[1] * v0[1]) + (v0[2] * v0[2] + v0[3] * v0[3]) + (v1[0] * v1[0] + v1[1] * v1[1]) + (v1[2] * v1[2] + v1[3] * v1[3]); }
                ss += __shfl_xor(ss, 16); ss += __shfl_xor(ss, 32);
                if (fq == 0) atomicAdd(sumsq + row, ss); }
    }
};
struct EpiGU {
    static constexpr bool PERM = true, AFTER_DRAIN = false, HOOK = false;
    const float* sumsq; bf16_t* ACT;
    __device__ __forceinline__ void operator()(const f32x4 (&acc)[2][2][4][2], const Unit& u, int wr, int wc, int fr, int fq) const {
        const int row0 = u.pm * BM + wr * 64 + fr, col0 = u.pn * HALF + wc * 32 + 8 * fq;
#pragma unroll
        for (int ai = 0; ai < 2; ++ai)
#pragma unroll
            for (int m = 0; m < 4; ++m) { const size_t row = (size_t)(row0 + ai * HALF + m * 16);
                const float rstd = __builtin_amdgcn_rsqf(sumsq[row] * (1.0f / DM) + EPS);
                f32x4 o[2];
#pragma unroll
                for (int n = 0; n < 2; ++n)
#pragma unroll
                    for (int e = 0; e < 4; ++e) { const float g = acc[ai][0][m][n][e] * rstd, uu = acc[ai][1][m][n][e] * rstd; o[n][e] = g * sigmoidf_(g) * uu; }
                *(u32x4*)(ACT + row * DFF + col0) = pack8(o[0], o[1]); }
    }
};
struct EpiDown {
    static constexpr bool PERM = true, AFTER_DRAIN = false, HOOK = false;
    const bf16_t* XB; float* out;
    __device__ __forceinline__ void operator()(const f32x4 (&acc)[2][2][4][2], const Unit& u, int wr, int wc, int fr, int fq) const {
        const int row0 = u.pm * BM + wr * 64 + fr, col0 = u.pn * BM + wc * 32 + 8 * fq;
#pragma unroll
        for (int ai = 0; ai < 2; ++ai)
#pragma unroll
            for (int m = 0; m < 4; ++m) { const size_t row = (size_t)(row0 + ai * HALF + m * 16);
#pragma unroll
                for (int bj = 0; bj < 2; ++bj) { const size_t off = row * DM + col0 + bj * HALF;
                    f32x4 a0, a1; unpack8(*(const u32x4*)(XB + off), a0, a1);
                    *(f32x4*)(out + off) = a0 + acc[ai][bj][m][0]; *(f32x4*)(out + off + 4) = a1 + acc[ai][bj][m][1]; } }
    }
};
template <class Epi, class Sched, bool ALIGN_EPI = false, bool SP2 = false>
__device__ __forceinline__ void gemm_phase(PG8_LAS unsigned char* lds, const Gemm g, const Sched& S, const Epi& E, int tid_l) {
    const int tid = tid_l, wid = __builtin_amdgcn_readfirstlane(tid >> 6), lane = tid & 63, wr = wid >> 2, wc = wid & 3, fr = lane & 15, fq = lane >> 4;
    const int K = g.K, nt = K / BK;
    unsigned voffA[2], voffB[2];
#pragma unroll
    for (int i = 0; i < 2; ++i) { int R, C; stage_rc(tid * 16 + i * 8192, R, C); const int Rb = Epi::PERM ? ((R & ~31) + perm32(R & 31)) : R;
        voffA[i] = (unsigned)(R * K + C) * 2u; voffB[i] = (unsigned)(Rb * K + C) * 2u; }
    const size_t kstep = (size_t)(BK * 2);
    const size_t hstep = (size_t)HALF * K * 2;
    const size_t tstep = 2 * hstep;
    const unsigned ldsw = (unsigned)wid * 1024u;
    const int aoff = lds_byte(wr * 64 + fr, fq * 8), boff = lds_byte(wc * 32 + fr, fq * 8);
#define PG8_SA(b, h) (((b) * 2 + (h)) * HTB)
#define PG8_SB(b, h) ((4 + (b) * 2 + (h)) * HTB)
#define PG8_STAGE(bufoff, gbase, voff) do { _Pragma("unroll") for (int _i = 0; _i < 2; ++_i) \
        __builtin_amdgcn_global_load_lds((const unsigned*)((const char*)(gbase) + (voff)[_i]), (PG8_LAS unsigned*)(lds + (bufoff) + ldsw + _i * 8192), 16, 0, 0); } while (0)
#define PG8_LDA(dst, b, h) do { _Pragma("unroll") for (int m = 0; m < 4; ++m) _Pragma("unroll") for (int k = 0; k < 2; ++k) dst[m][k] = *(const PG8_LAS bf16x8*)(lds + PG8_SA(b, h) + aoff + m * 2048 + k * 1024); } while (0)
#define PG8_LDB(dst, b, h) do { _Pragma("unroll") for (int n = 0; n < 2; ++n) _Pragma("unroll") for (int k = 0; k < 2; ++k) dst[n][k] = *(const PG8_LAS bf16x8*)(lds + PG8_SB(b, h) + boff + n * 2048 + k * 1024); } while (0)
#define PG8_MMA(ai, bj, At, Bt) do { __builtin_amdgcn_s_setprio(1); _Pragma("unroll") for (int m = 0; m < 4; ++m) _Pragma("unroll") for (int n = 0; n < 2; ++n) _Pragma("unroll") for (int k = 0; k < 2; ++k) \
        acc[ai][bj][m][n] = __builtin_amdgcn_mfma_f32_16x16x32_bf16(Bt[n][k], At[m][k], acc[ai][bj][m][n], 0, 0, 0); __builtin_amdgcn_s_setprio(0); } while (0)
#define PG8_WAIT_V(n) asm volatile("s_waitcnt vmcnt(" #n ")" ::: "memory")
#define PG8_WAIT_L(n) asm volatile("s_waitcnt lgkmcnt(" #n ")" ::: "memory")
#define PG8_BAR __builtin_amdgcn_s_barrier()
#define PG8_SCHED __builtin_amdgcn_sched_barrier(0)
    Unit cur, nxt; int ui = 0;
    if (!S.next(0, cur)) return;
    f32x4 acc[2][2][4][2];
#pragma unroll
    for (int a = 0; a < 2; ++a)
#pragma unroll
        for (int b = 0; b < 2; ++b)
#pragma unroll
            for (int m = 0; m < 4; ++m)
#pragma unroll
                for (int n = 0; n < 2; ++n) acc[a][b][m][n] = (f32x4){0.f, 0.f, 0.f, 0.f};
    bf16x8 At[4][2], B0[2][2], B1[2][2];
    const char* cA = (const char*)g.A + (size_t)cur.pm * tstep; const char* cB = (const char*)g.Bt + (size_t)cur.pn * tstep;
    S.a_ready(cur);
    if constexpr (SP2) {
        PG8_STAGE(PG8_SB(0, 0), cB, voffB); PG8_STAGE(PG8_SB(0, 1), cB + hstep, voffB); PG8_STAGE(PG8_SA(0, 0), cA, voffA); PG8_STAGE(PG8_SA(0, 1), cA + hstep, voffA);
        if (wr == 1) PG8_BAR;
        PG8_WAIT_V(2); PG8_BAR;
        PG8_STAGE(PG8_SB(1, 0), cB + kstep, voffB); PG8_STAGE(PG8_SA(1, 0), cA + kstep, voffA); PG8_STAGE(PG8_SB(1, 1), cB + hstep + kstep, voffB);
        PG8_WAIT_V(6); PG8_BAR;
    } else {
        PG8_STAGE(PG8_SB(0, 0), cB, voffB); PG8_STAGE(PG8_SA(0, 0), cA, voffA); PG8_STAGE(PG8_SB(0, 1), cB + hstep, voffB); PG8_STAGE(PG8_SA(0, 1), cA + hstep, voffA);
        if (wr == 1) PG8_BAR;
        PG8_WAIT_V(4); PG8_BAR;
        PG8_STAGE(PG8_SB(1, 0), cB + kstep, voffB); PG8_STAGE(PG8_SA(1, 0), cA + kstep, voffA); PG8_STAGE(PG8_SB(1, 1), cB + hstep + kstep, voffB);
        PG8_WAIT_V(6); PG8_BAR;
    }
    for (;;) {
        const bool has_next = S.next(ui + 1, nxt);
        const char* nA = has_next ? (const char*)g.A + (size_t)nxt.pm * tstep : cA; const char* nB = has_next ? (const char*)g.Bt + (size_t)nxt.pn * tstep : cB;
        for (int t = 0; t < nt; t += 2) {
            if constexpr (Epi::HOOK) { if (t == E.hook_t) E.hook(acc, cur, wr, wc, fr, fq); }
            const bool last = (t == nt - 2);
            const char* a1 = cA + (size_t)(t + 1) * kstep;
            const char* a2 = last ? nA : cA + (size_t)(t + 2) * kstep; const char* b2 = last ? nB : cB + (size_t)(t + 2) * kstep;
            const char* a3 = a2 + kstep; const char* b3 = b2 + kstep;
            if (last && has_next) S.a_ready(nxt);
            if constexpr (SP2) {
            PG8_LDB(B0, 0, 0); PG8_LDB(B1, 0, 1); PG8_SCHED; PG8_LDA(At, 0, 0); PG8_STAGE(PG8_SA(1, 1), a1 + hstep, voffA);
            PG8_WAIT_V(8); PG8_WAIT_L(0); PG8_BAR; PG8_MMA(0, 0, At, B0); PG8_MMA(0, 1, At, B1); PG8_BAR; PG8_SCHED;
            PG8_LDA(At, 0, 1); PG8_STAGE(PG8_SB(0, 0), b2, voffB); PG8_STAGE(PG8_SB(0, 1), b2 + hstep, voffB); PG8_STAGE(PG8_SA(0, 0), a2, voffA);
            PG8_WAIT_V(8); PG8_WAIT_L(0); PG8_BAR; PG8_MMA(1, 0, At, B0); PG8_MMA(1, 1, At, B1); PG8_BAR; PG8_SCHED;
            PG8_LDB(B0, 1, 0); PG8_LDB(B1, 1, 1); PG8_SCHED; PG8_LDA(At, 1, 0); PG8_STAGE(PG8_SA(0, 1), a2 + hstep, voffA);
            PG8_WAIT_V(8); PG8_WAIT_L(0); PG8_BAR; PG8_MMA(0, 0, At, B0); PG8_MMA(0, 1, At, B1); PG8_BAR; PG8_SCHED;
            PG8_LDA(At, 1, 1); PG8_STAGE(PG8_SB(1, 0), b3, voffB); PG8_STAGE(PG8_SB(1, 1), b3 + hstep, voffB); PG8_STAGE(PG8_SA(1, 0), a3, voffA);
            PG8_WAIT_V(8); PG8_WAIT_L(0); PG8_BAR; PG8_MMA(1, 0, At, B0); PG8_MMA(1, 1, At, B1); PG8_BAR; PG8_SCHED;
            } else {
            PG8_LDB(B0, 0, 0); PG8_SCHED; PG8_LDA(At, 0, 0); PG8_STAGE(PG8_SA(1, 1), a1 + hstep, voffA);
            PG8_WAIT_L(8); PG8_BAR; PG8_WAIT_L(0); PG8_MMA(0, 0, At, B0); PG8_BAR; PG8_SCHED;
            PG8_LDB(B1, 0, 1); PG8_STAGE(PG8_SB(0, 0), b2, voffB);
            PG8_BAR; PG8_WAIT_L(0); PG8_MMA(0, 1, At, B1); PG8_BAR;
            PG8_LDA(At, 0, 1); PG8_STAGE(PG8_SA(0, 0), a2, voffA);
            PG8_BAR; PG8_WAIT_L(0); PG8_MMA(1, 0, At, B0); PG8_BAR; PG8_SCHED;
            PG8_STAGE(PG8_SB(0, 1), b2 + hstep, voffB);
            PG8_WAIT_V(6); PG8_BAR; PG8_MMA(1, 1, At, B1); PG8_BAR;
            PG8_LDB(B0, 1, 0); PG8_SCHED; PG8_LDA(At, 1, 0); PG8_STAGE(PG8_SA(0, 1), a2 + hstep, voffA);
            PG8_WAIT_L(8); PG8_BAR; PG8_WAIT_L(0); PG8_MMA(0, 0, At, B0); PG8_BAR; PG8_SCHED;
            PG8_LDB(B1, 1, 1); PG8_STAGE(PG8_SB(1, 0), b3, voffB);
            PG8_BAR; PG8_WAIT_L(0); PG8_MMA(0, 1, At, B1); PG8_BAR;
            PG8_LDA(At, 1, 1); PG8_STAGE(PG8_SA(1, 0), a3, voffA);
            PG8_BAR; PG8_WAIT_L(0); PG8_MMA(1, 0, At, B0); PG8_BAR; PG8_SCHED;
            PG8_STAGE(PG8_SB(1, 1), b3 + hstep, voffB);
            PG8_WAIT_V(6); PG8_BAR; PG8_MMA(1, 1, At, B1); PG8_BAR;
            }
        }
        if constexpr (ALIGN_EPI) { if (wr == 0) PG8_BAR; }
        if constexpr (!Epi::AFTER_DRAIN) { E(acc, cur, wr, wc, fr, fq); S.done(cur); }
        if (!has_next) break;
#pragma unroll
        for (int a = 0; a < 2; ++a)
#pragma unroll
            for (int b = 0; b < 2; ++b)
#pragma unroll
                for (int m = 0; m < 4; ++m)
#pragma unroll
                    for (int n = 0; n < 2; ++n) acc[a][b][m][n] = (f32x4){0.f, 0.f, 0.f, 0.f};
        cur = nxt; cA = nA; cB = nB; ++ui;
        if constexpr (ALIGN_EPI) { if (wr == 1) PG8_BAR; }
    }
    PG8_WAIT_V(0);
    if constexpr (!ALIGN_EPI) { if (wr == 0) PG8_BAR; }
    PG8_BAR;
    if constexpr (Epi::AFTER_DRAIN) { E.fused(acc, cur, wr, wc, fr, fq, lds, wid, lane); S.done(cur); }
#undef PG8_SA
#undef PG8_SB
#undef PG8_STAGE
#undef PG8_LDA
#undef PG8_LDB
#undef PG8_MMA
#undef PG8_WAIT_V
#undef PG8_WAIT_L
#undef PG8_BAR
#undef PG8_SCHED
}
}
namespace att {
using bf16 = __hip_bfloat16;
constexpr int D = 128, NW = 8, QBLK = 32, KVBLK = 64;
constexpr float SCALE = 0.088388347648318440f;
constexpr float THR = 8.f;
constexpr int SDEPTH = 2;
constexpr size_t SHM_V = KVBLK * D * 2, SHM_K = KVBLK * D * 2, SHM_ATTN = 2 * SHM_V + 2 * SHM_K + NW * 64 * 4;
using bf16x8 = __attribute__((ext_vector_type(8))) short;
using s16x4  = __attribute__((ext_vector_type(4))) short;
using f32x16 = __attribute__((ext_vector_type(16))) float;
using f32x8  = __attribute__((ext_vector_type(8))) float;
using u32x4  = __attribute__((ext_vector_type(4))) unsigned;
#define KSWZ(row, colB) ((row) * 256 + ((colB) ^ (((row) & 7) << 4)))
#define SBAR() __builtin_amdgcn_sched_barrier(0)
__device__ __forceinline__ int crow(int r, int hi) { return (r & 3) + 8 * (r >> 2) + 4 * hi; }
__device__ __forceinline__ unsigned cvtpk(float lo, float hi) {
  unsigned r; asm volatile("v_cvt_pk_bf16_f32 %0, %1, %2" : "=v"(r) : "v"(lo), "v"(hi)); return r;
}
template <typename TIn> struct Stage;
template <> struct Stage<bf16>  { using T = bf16x8;
  __device__ static __forceinline__ T ld8(const bf16* p) { return *reinterpret_cast<const bf16x8*>(p); }
  __device__ static __forceinline__ bf16x8 tobf(T x) { return x; } };
template <> struct Stage<float> { using T = f32x8;
  __device__ static __forceinline__ T ld8(const float* p) { return *reinterpret_cast<const f32x8*>(p); }
  __device__ static __forceinline__ bf16x8 tobf(T x) {
    u32x4 w = {cvtpk(x[0], x[1]), cvtpk(x[2], x[3]), cvtpk(x[4], x[5]), cvtpk(x[6], x[7])}; return *reinterpret_cast<bf16x8*>(&w); } };

__device__ __forceinline__ void partialSM(f32x16& p0, f32x16& p1, float& m_reg, float& mn, float& alpha) {
  constexpr float C = SCALE * 1.4426950408889634f;
  float pmax = p0[0]; for (int r = 1; r < 16; ++r) pmax = fmaxf(pmax, p0[r]); for (int r = 0; r < 16; ++r) pmax = fmaxf(pmax, p1[r]);
  { auto rr = __builtin_amdgcn_permlane32_swap(__float_as_uint(pmax), __float_as_uint(pmax), false, false);
    pmax = fmaxf(__uint_as_float(rr[0]), __uint_as_float(rr[1])); }
  if (__builtin_expect(__all(pmax - m_reg <= THR / SCALE), 1)) { mn = m_reg; alpha = 1.f; }
  else { mn = fmaxf(m_reg, pmax); alpha = __builtin_amdgcn_exp2f((m_reg - mn) * C); m_reg = mn; }
  float mnC = -mn * C;
  for (int r = 0; r < 16; ++r) p0[r] = fmaf(p0[r], C, mnC); for (int r = 0; r < 16; ++r) p1[r] = fmaf(p1[r], C, mnC);
  for (int r = 0; r < 16; ++r) p0[r] = __builtin_amdgcn_exp2f(p0[r]);
}
__device__ __forceinline__ void finishSM(f32x16& p0, f32x16& p1, float alpha, float& l_reg, bf16x8& pa0, bf16x8& pa1, bf16x8& pa2, bf16x8& pa3) {
  for (int r = 0; r < 16; ++r) p1[r] = __builtin_amdgcn_exp2f(p1[r]);
  float ps = 0; for (int r = 0; r < 16; ++r) ps += p0[r]; for (int r = 0; r < 16; ++r) ps += p1[r];
  { auto rr = __builtin_amdgcn_permlane32_swap(__float_as_uint(ps), __float_as_uint(ps), false, false);
    ps = __uint_as_float(rr[0]) + __uint_as_float(rr[1]); }
  l_reg = l_reg * alpha + ps;
#define PK4(P, BASE, OUT) do { unsigned a0 = cvtpk(P[BASE + 0], P[BASE + 1]), a1 = cvtpk(P[BASE + 2], P[BASE + 3]);   \
    unsigned b0 = cvtpk(P[BASE + 4], P[BASE + 5]), b1 = cvtpk(P[BASE + 6], P[BASE + 7]);                              \
    auto r0 = __builtin_amdgcn_permlane32_swap(a0, b0, false, false); auto r1 = __builtin_amdgcn_permlane32_swap(a1, b1, false, false); \
    u32x4 w = {r0[0], r1[0], r0[1], r1[1]}; OUT = *reinterpret_cast<bf16x8*>(&w); } while (0)
  PK4(p0, 0, pa0); PK4(p0, 8, pa1); PK4(p1, 0, pa2); PK4(p1, 8, pa3);
#undef PK4
}
__device__ __forceinline__ void qkt(f32x16& p0, f32x16& p1, const bf16* Ks, const bf16x8* qr, int r32, int hi) {
  p0 = f32x16{}; p1 = f32x16{};
  for (int d0 = 0; d0 < 8; ++d0) { int cb = (d0 * 16 + hi * 8) * 2;
    bf16x8 b0 = *reinterpret_cast<const bf16x8*>((const char*)Ks + KSWZ(r32, cb));
    bf16x8 b1 = *reinterpret_cast<const bf16x8*>((const char*)Ks + KSWZ(32 + r32, cb));
    p0 = __builtin_amdgcn_mfma_f32_32x32x16_bf16(b0, qr[d0], p0, 0, 0, 0);
    p1 = __builtin_amdgcn_mfma_f32_32x32x16_bf16(b1, qr[d0], p1, 0, 0, 0); }
}
__device__ __forceinline__ int v_st(int k, int c) { const int kk = (k & ~0xC) | ((k & 4) << 1) | ((k & 8) >> 1); return ((kk >> 3) * 4 + (c >> 5)) * 512 + ((kk & 7) * 32 + (c & 31)) * 2; }
__device__ __forceinline__ int v_rd_base(int lane) { return ((lane & 3) << 3) | (((lane >> 2) & 3) << 6) | (((lane >> 4) & 1) << 5) | (((lane >> 5) & 1) << 8); }
constexpr int v_rd_off(int d0, int ks, int half) { return d0 * 512 + ks * 4096 + half * 2048; }
template <int OFF> __device__ __forceinline__ s16x4 tr_read(int vb) {
  s16x4 r; asm volatile("ds_read_b64_tr_b16 %0, %1 offset:%2" : "=&v"(r) : "v"(vb), "i"(OFF) : "memory"); return r;
}
template <int D0> __device__ __forceinline__ void pv_one(f32x16& od, int vb, bf16x8 pa0, bf16x8 pa1, bf16x8 pa2, bf16x8 pa3) {
  const s16x4 l0 = tr_read<v_rd_off(D0, 0, 0)>(vb), h0 = tr_read<v_rd_off(D0, 0, 1)>(vb), l1 = tr_read<v_rd_off(D0, 1, 0)>(vb), h1 = tr_read<v_rd_off(D0, 1, 1)>(vb);
  const s16x4 l2 = tr_read<v_rd_off(D0, 2, 0)>(vb), h2 = tr_read<v_rd_off(D0, 2, 1)>(vb), l3 = tr_read<v_rd_off(D0, 3, 0)>(vb), h3 = tr_read<v_rd_off(D0, 3, 1)>(vb);
  asm volatile("s_waitcnt lgkmcnt(0)" ::: "memory"); SBAR();
#define PK(L, H) (bf16x8){L[0], L[1], L[2], L[3], H[0], H[1], H[2], H[3]}
  od = __builtin_amdgcn_mfma_f32_32x32x16_bf16(pa0, PK(l0, h0), od, 0, 0, 0);
  od = __builtin_amdgcn_mfma_f32_32x32x16_bf16(pa1, PK(l1, h1), od, 0, 0, 0);
  od = __builtin_amdgcn_mfma_f32_32x32x16_bf16(pa2, PK(l2, h2), od, 0, 0, 0);
  od = __builtin_amdgcn_mfma_f32_32x32x16_bf16(pa3, PK(l3, h3), od, 0, 0, 0);
#undef PK
}
__device__ __forceinline__ void pv_d0(f32x16* o, int vb, bf16x8 pa0, bf16x8 pa1, bf16x8 pa2, bf16x8 pa3) {
  pv_one<0>(o[0], vb, pa0, pa1, pa2, pa3); pv_one<1>(o[1], vb, pa0, pa1, pa2, pa3); pv_one<2>(o[2], vb, pa0, pa1, pa2, pa3); pv_one<3>(o[3], vb, pa0, pa1, pa2, pa3);
}

template <int LDQ, int LDK, int LDO>
__device__ __forceinline__ void attn_dense_body(const bf16* __restrict__ Qb, const bf16* __restrict__ Kh, const bf16* __restrict__ Vh,
                                                bf16* __restrict__ Ob, int seq, char* lds, int tid_l) {
  using St = Stage<bf16>;
  const int tid = tid_l, wid = tid >> 6, lane = tid & 63, r32 = lane & 31, hi = lane >> 5;
  bf16* V_lds = (bf16*)lds; bf16* K_lds = (bf16*)(lds + 2 * SHM_V);
  float* ws = (float*)(lds + 2 * SHM_V + 2 * SHM_K) + wid * 64; float* li_l = ws; float* al_l = ws + 32;
  float m_reg = -1e30f, l_reg = 0; f32x16 o[4] = {}; bf16x8 qr[8];
  const bf16* Qw = Qb + (long)(wid * QBLK + r32) * LDQ + hi * 8;
#pragma unroll
  for (int d0 = 0; d0 < 8; ++d0) qr[d0] = St::ld8(Qw + d0 * 16);
  const int sr = tid >> 4, sc = (tid & 15) * 8, vst0 = v_st(sr, sc), vst1 = v_st(32 + sr, sc);
  const int vb0 = (int)(uintptr_t)V_lds + v_rd_base(lane);
  struct { typename St::T vs0, vs1, ks0, ks1; } sr_[SDEPTH];
#define SLOAD(i, k0) do { sr_[i].vs0 = St::ld8(&Vh[(long)((k0) + sr) * LDK + sc]); sr_[i].vs1 = St::ld8(&Vh[(long)((k0) + 32 + sr) * LDK + sc]); \
    sr_[i].ks0 = St::ld8(&Kh[(long)((k0) + sr) * LDK + sc]); sr_[i].ks1 = St::ld8(&Kh[(long)((k0) + 32 + sr) * LDK + sc]); } while (0)
#define SWRITE(b, i) do { *(bf16x8*)((char*)V_lds + (b) * SHM_V + vst0) = St::tobf(sr_[i].vs0);          \
    *(bf16x8*)((char*)V_lds + (b) * SHM_V + vst1) = St::tobf(sr_[i].vs1); int kc = sc * 2;               \
    *(bf16x8*)((char*)K_lds + (b) * SHM_K + KSWZ(sr, kc)) = St::tobf(sr_[i].ks0);                       \
    *(bf16x8*)((char*)K_lds + (b) * SHM_K + KSWZ(32 + sr, kc)) = St::tobf(sr_[i].ks1); } while (0)
#define SWAIT() do { if constexpr (SDEPTH == 2) asm volatile("s_waitcnt vmcnt(4)" ::: "memory"); else asm volatile("s_waitcnt vmcnt(0)" ::: "memory"); } while (0)
#define RESC(a) do { if (__any((a) < 1.f)) { if (hi == 0) al_l[r32] = (a); asm volatile("s_waitcnt lgkmcnt(0)" ::: "memory"); \
    for (int d = 0; d < 4; ++d) for (int r = 0; r < 16; ++r) o[d][r] *= al_l[crow(r, hi)]; } } while (0)
  f32x16 pA0, pA1, pB0, pB1; float mnA, mnB, alA, alB; bf16x8 pa0, pa1, pa2, pa3; const int NT = seq / KVBLK;
  constexpr int SE = 0, SO = SDEPTH - 1;
  SLOAD(SE, 0); asm volatile("s_waitcnt vmcnt(0)" ::: "memory"); SWRITE(0, SE); __syncthreads();
  qkt(pA0, pA1, K_lds, qr, r32, hi); partialSM(pA0, pA1, m_reg, mnA, alA);
  SLOAD(SO, KVBLK); if constexpr (SDEPTH == 2) { if (2 < NT) SLOAD(SE, 2 * KVBLK); }
  SWAIT(); SWRITE(1, SO); __syncthreads();
  for (int j = 1; j + 1 < NT; j += 2) {
    SBAR(); qkt(pB0, pB1, (bf16*)((char*)K_lds + SHM_K), qr, r32, hi);
    finishSM(pA0, pA1, alA, l_reg, pa0, pa1, pa2, pa3); SBAR();
    SLOAD(SO, (j + SDEPTH) * KVBLK); SBAR();
    pv_d0(o, vb0, pa0, pa1, pa2, pa3); partialSM(pB0, pB1, m_reg, mnB, alB);
    __syncthreads(); SWAIT(); SWRITE(0, SE);
    RESC(alB); __syncthreads();
    SBAR(); qkt(pA0, pA1, K_lds, qr, r32, hi);
    finishSM(pB0, pB1, alB, l_reg, pa0, pa1, pa2, pa3); SBAR();
    if (SDEPTH == 1 || j + 3 < NT) SLOAD(SE, (j + 1 + SDEPTH) * KVBLK); SBAR();
    pv_d0(o, vb0 + (int)SHM_V, pa0, pa1, pa2, pa3); partialSM(pA0, pA1, m_reg, mnA, alA);
    __syncthreads(); SWAIT(); SWRITE(1, SO);
    RESC(alA); __syncthreads();
  }
  SBAR(); qkt(pB0, pB1, (bf16*)((char*)K_lds + SHM_K), qr, r32, hi);
  finishSM(pA0, pA1, alA, l_reg, pa0, pa1, pa2, pa3); SBAR();
  pv_d0(o, vb0, pa0, pa1, pa2, pa3); partialSM(pB0, pB1, m_reg, mnB, alB);
  __syncthreads(); RESC(alB);
  finishSM(pB0, pB1, alB, l_reg, pa0, pa1, pa2, pa3); SBAR();
  pv_d0(o, vb0 + (int)SHM_V, pa0, pa1, pa2, pa3);
  if (hi == 0) li_l[r32] = l_reg; asm volatile("s_waitcnt lgkmcnt(0)" ::: "memory");
  float rli[16];
#pragma unroll
  for (int r = 0; r < 16; ++r) rli[r] = __builtin_amdgcn_rcpf(li_l[crow(r, hi)]);
  bf16* Ow = Ob + (long)(wid * QBLK) * LDO;
#pragma unroll
  for (int r = 0; r < 16; ++r) { int orow = crow(r, hi);
    for (int d0 = 0; d0 < 4; ++d0) Ow[(long)orow * LDO + d0 * 32 + r32] = __float2bfloat16(o[d0][r] * rli[r]); }
#undef SLOAD
#undef SWRITE
#undef SWAIT
  __syncthreads();
}

__device__ __forceinline__ void attn_b_unit(const bf16* __restrict__ P, bf16* __restrict__ OBG, float* __restrict__ LSE, const float* btab, char* vlds, float* ws, int unit, int lane) {
  using St = Stage<bf16>;
  const int r32 = lane & 31, hi = lane >> 5;
  const int g = unit >> 10, rest = unit & 1023, b = rest >> 8, h = (rest >> 6) & 3, idx = rest & 63;
  const int dsh = 2 * g, d = 1 << dsh, rd = idx & (d - 1), qblk = idx >> dsh;
  const int kq = 32 * qblk + r32;
  const int tq = rd + (kq << dsh);
  float* li_l = ws; float* al_l = ws + 32;
  float m_reg = -1e30f, l_reg = 0; f32x16 o[4] = {};
  const int vb0 = (int)(uintptr_t)vlds + v_rd_base(lane);
  const int srow = lane >> 4, sc = (lane & 15) * 8;
  const bf16* Qp = P + (size_t)(b * SEQ + tq) * INW + C_QB + g * 512 + h * 128 + hi * 8;
  bf16x8 qr[8];
#pragma unroll
  for (int d0 = 0; d0 < 8; ++d0) qr[d0] = St::ld8(Qp + d0 * 16);
  const int L64 = (SEQ >> dsh) >> 6;
  int tlo = (32 * qblk - 64) >> 6, thi = (32 * qblk + 31 + 64) >> 6; tlo = tlo < 0 ? 0 : tlo; thi = thi > L64 - 1 ? L64 - 1 : thi;
  const size_t rstride = (size_t)d * INW;
  const bf16* Kb = P + (size_t)(b * SEQ + rd) * INW + C_KB + g * 512 + h * 128;
  const bf16* Vb = Kb + (C_VB - C_KB);
  const float* bt = btab + (g * 4 + h) * 129 + 64;
  for (int t = tlo; t <= thi; ++t) {
    const int k0 = t * 64;
    f32x16 p0 = {}, p1 = {};
    { const bf16* K0 = Kb + (size_t)(k0 + r32) * rstride + hi * 8; const bf16* K1 = K0 + 32 * rstride;
#pragma unroll
      for (int d0 = 0; d0 < 8; ++d0) { const bf16x8 b0 = St::ld8(K0 + d0 * 16), b1 = St::ld8(K1 + d0 * 16);
        p0 = __builtin_amdgcn_mfma_f32_32x32x16_bf16(b0, qr[d0], p0, 0, 0, 0);
        p1 = __builtin_amdgcn_mfma_f32_32x32x16_bf16(b1, qr[d0], p1, 0, 0, 0); } }
    { const bf16* V0 = Vb + (size_t)(k0 + srow) * rstride + sc;
#pragma unroll
      for (int it = 0; it < 16; ++it) { const bf16x8 v = St::ld8(V0 + (size_t)(4 * it) * rstride); *(bf16x8*)(vlds + v_st(4 * it + srow, sc)) = v; } }
#pragma unroll
    for (int r = 0; r < 16; ++r) { const int rel = k0 + crow(r, hi) - kq; const int rc = rel < -64 ? -64 : (rel > 64 ? 64 : rel);
      p0[r] = (rel == rc) ? p0[r] + bt[rc] : -1e30f; }
#pragma unroll
    for (int r = 0; r < 16; ++r) { const int rel = k0 + 32 + crow(r, hi) - kq; const int rc = rel < -64 ? -64 : (rel > 64 ? 64 : rel);
      p1[r] = (rel == rc) ? p1[r] + bt[rc] : -1e30f; }
    float mn, alpha; bf16x8 pa0, pa1, pa2, pa3;
    partialSM(p0, p1, m_reg, mn, alpha);
    RESC(alpha);
    finishSM(p0, p1, alpha, l_reg, pa0, pa1, pa2, pa3);
    asm volatile("s_waitcnt lgkmcnt(0)" ::: "memory"); SBAR();
    pv_d0(o, vb0, pa0, pa1, pa2, pa3);
  }
  if (hi == 0) { li_l[r32] = l_reg; LSE[((size_t)g * TOK + b * SEQ + tq) * 4 + h] = m_reg * SCALE + __logf(l_reg); }
  asm volatile("s_waitcnt lgkmcnt(0)" ::: "memory");
  float rli[16];
#pragma unroll
  for (int r = 0; r < 16; ++r) rli[r] = __builtin_amdgcn_rcpf(li_l[crow(r, hi)]);
#pragma unroll
  for (int r = 0; r < 16; ++r) { const int i = crow(r, hi); bf16* Ow = OBG + ((size_t)g * TOK + b * SEQ + rd + ((32 * qblk + i) << dsh)) * 512 + h * 128 + r32;
    for (int d0 = 0; d0 < 4; ++d0) Ow[d0 * 32] = __float2bfloat16(o[d0][r] * rli[r]); }
  asm volatile("s_waitcnt lgkmcnt(0)" ::: "memory");
}
#undef RESC
}
#define LAS __attribute__((address_space(3)))
typedef unsigned short bf16r;
typedef unsigned v4u __attribute__((ext_vector_type(4)));
typedef float v4f __attribute__((ext_vector_type(4)));
constexpr int NWAVES = 8, NTHREADS = 512;
constexpr int LDS_BYTES = 147456, RING_BYTES = 131072;
constexpr size_t MiB = 1u << 20;
constexpr size_t WS_SUMSQ = 0;
constexpr size_t WS_BTAB = 64 * 1024;
constexpr size_t WS_CTRS = 96 * 1024;
constexpr size_t WS_NORMW = 112 * 1024;
constexpr size_t WS_XBAR = 256 * 1024;
constexpr size_t WS_ROPE = 128 * 1024;
constexpr size_t WS_WIN = 1 * MiB;
constexpr size_t WS_WPA = WS_WIN + (size_t)INW * DM * 2;
constexpr size_t WS_WOUT = WS_WPA + (size_t)DM * 2560 * 2;
constexpr size_t WS_WGU = WS_WOUT + (size_t)DM * DM * 2;
constexpr size_t WS_WDN = WS_WGU + (size_t)NGU * DM * 2;
constexpr size_t WS_XN = WS_WDN + (size_t)DM * DFF * 2;
constexpr size_t WS_OA = WS_XN + (size_t)TOK * DM * 2;
constexpr size_t WS_OB = WS_OA + (size_t)TOK * 2560 * 2;
constexpr size_t WS_MG = WS_OB + (size_t)TOK * 512 * 2;
constexpr size_t WS_P = WS_MG + (size_t)TOK * DM * 2;
constexpr size_t WS_OBG = WS_P + (size_t)TOK * INW * 2;
constexpr size_t WS_LSE = WS_OBG + (size_t)3 * TOK * 512 * 2;
constexpr size_t WS_KVA = WS_LSE + (size_t)3 * TOK * 4 * 4;
constexpr size_t WS_END = WS_KVA + (size_t)BATCH * 8 * SEQ * 128 * 2;

__device__ __forceinline__ unsigned f2bf(float f) { unsigned u = __builtin_bit_cast(unsigned, f); return (u + 0x7fffu + ((u >> 16) & 1u)) >> 16; }
__device__ __forceinline__ unsigned pk2(float lo, float hi) { return f2bf(lo) | (f2bf(hi) << 16); }
__device__ __forceinline__ float wave_sum(float v) {
#pragma unroll
    for (int o = 1; o < 64; o <<= 1) v += __shfl_xor(v, o);
    return v;
}
struct CvtItem { const float* src; bf16r* dst; const float* kscale; int N, K, k0, n0, drow0, perm; };
__device__ __forceinline__ void cvt_load(const CvtItem& c, v4f (&r)[16], int lane) {
    const int lr = lane >> 4, lc = (lane & 15) * 4; const float* p = c.src + (size_t)(c.k0 + lr) * c.N + c.n0 + lc;
#pragma unroll
    for (int i = 0; i < 16; ++i) r[i] = *(const v4f*)(p + (size_t)(4 * i) * c.N);
}
__device__ __forceinline__ void cvt_process(const CvtItem& c, v4f (&r)[16], LAS float* scr, int lane) {
    const int lr = lane >> 4, lc = (lane & 15) * 4;
#pragma unroll
    for (int i = 0; i < 16; ++i) { const int kk = 4 * i + lr; v4f v = r[i];
        if (c.kscale) { const float sc = c.kscale[c.k0 + kk]; v = v * sc; }
        LAS float* d = scr + kk * 65 + lc; d[0] = v[0]; d[1] = v[1]; d[2] = v[2]; d[3] = v[3]; }
    asm volatile("s_waitcnt lgkmcnt(0)" ::: "memory");
    const int cc = lane & 7;
#pragma unroll
    for (int j = 0; j < 8; ++j) { const int n = (lane >> 3) + 8 * j; const LAS float* sp = scr + (8 * cc) * 65 + n;
        v4u o; o.x = pg8::cvt_pk_bf16(sp[0 * 65], sp[1 * 65]); o.y = pg8::cvt_pk_bf16(sp[2 * 65], sp[3 * 65]); o.z = pg8::cvt_pk_bf16(sp[4 * 65], sp[5 * 65]); o.w = pg8::cvt_pk_bf16(sp[6 * 65], sp[7 * 65]);
        const int nd = c.perm ? (((n & 31) >> 2) * 8 + (n >> 5) * 4 + (n & 3)) : n;
        *(v4u*)(c.dst + (size_t)(c.drow0 + nd) * c.K + c.k0 + 8 * cc) = o; }
    asm volatile("s_waitcnt lgkmcnt(0)" ::: "memory");
}
template <class Decode, class Next>
__device__ __forceinline__ void cvt_run(const Decode& dec, Next& next, LAS float* scr, int lane) {
    v4f ra[16], rb[16]; CvtItem ia, ib;
    int ida = next(); if (ida < 0) return;
    ia = dec(ida); cvt_load(ia, ra, lane);
    for (;;) {
        const int idb = next(); if (idb >= 0) { ib = dec(idb); cvt_load(ib, rb, lane); }
        cvt_process(ia, ra, scr, lane);
        if (idb < 0) break;
        ida = next(); if (ida >= 0) { ia = dec(ida); cvt_load(ia, ra, lane); }
        cvt_process(ib, rb, scr, lane);
        if (ida < 0) break;
    }
}
struct NextStatic { int cur, step, total; __device__ __forceinline__ int operator()() { const int v = cur; cur += step; return v < total ? v : -1; } };
struct NextQueue { unsigned* ctr; int total, lane; int cur = 0, end = 0; static constexpr int CH = 8;
    __device__ __forceinline__ int operator()() { if (cur >= end) { unsigned v = 0; if (lane == 0) v = atomicAdd(ctr, (unsigned)CH); v = __builtin_amdgcn_readfirstlane(v); if (v >= (unsigned)total) return -1; cur = (int)v; end = cur + CH < total ? cur + CH : total; } return cur++; } };

#define XB_TMO      128
#define XB_XCNT(j)  (256  + 64 * (j))
#define XB_XSUB(j)  (1280 + 64 * (j))
#define XB_XGEN(j)  (2304 + 64 * (j))
#define XB_TOP      3328
#define XB_TOPGEN   3392
#define XCD_BAR_WORDS 3456
#define XB_SPIN_CAP (1u << 18)

__device__ __forceinline__ unsigned xb_ld(unsigned* p)              { return __hip_atomic_load(p, __ATOMIC_RELAXED, __HIP_MEMORY_SCOPE_AGENT); }
__device__ __forceinline__ unsigned xb_add(unsigned* p, unsigned v) { return __hip_atomic_fetch_add(p, v, __ATOMIC_RELAXED, __HIP_MEMORY_SCOPE_AGENT); }
__device__ __forceinline__ unsigned xb_xcc_id() { return (unsigned)__builtin_amdgcn_s_getreg((3 << 11) | 20) & 0xFu; }
#define XB_SPIN(cond, bar) do { unsigned _sp = 0; while (cond) { __builtin_amdgcn_s_sleep(1); \
    if ((++_sp & 255u) == 0u) { if (xb_ld(&(bar)[XB_TMO])) break; if (_sp > XB_SPIN_CAP) { atomicAdd(&(bar)[XB_TMO], 1u); break; } } } } while (0)

struct XcdBarrier {
    unsigned* bar; unsigned x;
    volatile LAS unsigned* st;
};

__device__ __forceinline__ XcdBarrier xcd_barrier_post(unsigned* bar, volatile LAS unsigned* st) {
    XcdBarrier b; b.bar = bar; b.x = xb_xcc_id(); b.st = st;
    if (threadIdx.x == 0) (void)xb_add(&bar[XB_XCNT(b.x)], 1u);
    return b;
}
__device__ __forceinline__ void xcd_barrier_complete(unsigned* bar, unsigned x, unsigned& nloc, unsigned& nx) {
    const unsigned G = gridDim.x * gridDim.y * gridDim.z;
    unsigned sum, cnt, mine, sp = 0u;
    for (;;) {
        sum = 0u; cnt = 0u; mine = 0u;
#pragma unroll
        for (unsigned j = 0; j < 16; ++j) { const unsigned c = xb_ld(&bar[XB_XCNT(j)]); sum += c; cnt += (c > 0u) ? 1u : 0u; mine = (j == x) ? c : mine; }
        if (sum == G) break;
        __builtin_amdgcn_s_sleep(1);
        if ((++sp & 255u) == 0u) { if (xb_ld(&bar[XB_TMO])) break; if (sp > XB_SPIN_CAP) { atomicAdd(&bar[XB_TMO], 1u); break; } }
    }
    nloc = mine > 0u ? mine : 1u; nx = cnt > 0u ? cnt : 1u;
}

__device__ __forceinline__ void xcd_barrier(const XcdBarrier& b) {
    asm volatile("s_waitcnt vmcnt(0)" ::: "memory");
    __syncthreads();
    if (threadIdx.x == 0) {
        unsigned* bar = b.bar;
        __builtin_amdgcn_s_waitcnt(0);
        unsigned nloc = b.st[0], nx = b.st[1];
        if (nloc == 0u) { xcd_barrier_complete(bar, b.x, nloc, nx); b.st[0] = nloc; b.st[1] = nx; }
        const unsigned old = xb_add(&bar[XB_XSUB(b.x)], 1u);
        const unsigned gen = old / nloc;
        if (old + 1u == (gen + 1u) * nloc) {
            __builtin_amdgcn_fence(__ATOMIC_RELEASE, "agent");
            asm volatile("s_waitcnt vmcnt(0)" ::: "memory");
            const unsigned og = xb_add(&bar[XB_TOP], 1u);
            const unsigned tg = og / nx;
            if (og + 1u == (tg + 1u) * nx) xb_add(&bar[XB_TOPGEN], 1u);
            else XB_SPIN(xb_ld(&bar[XB_TOPGEN]) == tg, bar);
            __builtin_amdgcn_fence(__ATOMIC_ACQUIRE, "agent");
            xb_add(&bar[XB_XGEN(b.x)], 1u);
            asm volatile("s_waitcnt vmcnt(0)" ::: "memory");
        } else {
            XB_SPIN(xb_ld(&bar[XB_XGEN(b.x)]) == gen, bar);
            __builtin_amdgcn_fence(__ATOMIC_ACQUIRE, "agent");
            asm volatile("s_waitcnt vmcnt(0)" ::: "memory");
        }
    }
    __syncthreads();
}


struct DecPlain { const float* w; bf16r* d; int N, K, perm_below;
    __device__ __forceinline__ CvtItem operator()(int r) const { CvtItem c; const int nb = N / 64, kb = r / nb, n0 = (r % nb) * 64; c.src = w; c.dst = d; c.kscale = nullptr; c.N = N; c.K = K; c.k0 = kb * 64; c.n0 = n0; c.drow0 = n0; c.perm = n0 < perm_below; return c; } };
struct DecGU { const float *wg, *wu, *n2; bf16r* d;
    static constexpr int I_G = 64 * (DFF / 64);
    __device__ __forceinline__ CvtItem operator()(int r) const { CvtItem c; const int which = r >= I_G; if (which) r -= I_G; const int nb = DFF / 64, kb = r / nb, n0 = (r % nb) * 64;
        c.src = which ? wu : wg; c.dst = d; c.kscale = n2; c.N = DFF; c.K = DM; c.k0 = kb * 64; c.n0 = n0; c.drow0 = (n0 >> 7) * 256 + which * 128 + (n0 & 127); c.perm = 0; return c; } };

struct Args { const float* in[16]; float* out; unsigned char* ws; };

__global__ void __launch_bounds__(NTHREADS) fwd_megakernel(Args a) {
    extern __shared__ __attribute__((aligned(16))) unsigned char lds[];
    cg::grid_group grid = cg::this_grid();
#define PH_BEGIN() unsigned char* wsl = a.ws; asm volatile("" : "+s"(wsl)); const int wave = wave_s; int lane; asm volatile("v_mbcnt_lo_u32_b32 %0, -1, 0\n\tv_mbcnt_hi_u32_b32 %0, -1, %0" : "=v"(lane)); const int tid = wave * 64 + lane; \
    const int G = gridDim.x, gw = blockIdx.x * NWAVES + wave, NGW = G * NWAVES; \
    (void)lane; (void)gw; (void)NGW; (void)wsl
#define A_x        (a.in[0])
#define A_norm1_g  (a.in[1])
#define A_w_in     (a.in[2])
#define A_b_gate   (a.in[3])
#define A_q_norm_a (a.in[4])
#define A_k_norm_a (a.in[5])
#define A_q_norm_b (a.in[6])
#define A_k_norm_b (a.in[7])
#define A_rel_bias (a.in[8])
#define A_w_pa     (a.in[9])
#define A_w_pb     (a.in[10])
#define A_w_out    (a.in[11])
#define A_norm2_g  (a.in[12])
#define A_w_gate   (a.in[13])
#define A_w_up     (a.in[14])
#define A_w_down   (a.in[15])
#define A_out      (a.out)
#define SUMSQ ((float*)(wsl + WS_SUMSQ))
#define BTAB  ((float*)(wsl + WS_BTAB))
#define CTRS  ((unsigned*)(wsl + WS_CTRS))
#define XBAR  ((unsigned*)(wsl + WS_XBAR))
#define NORMW ((float*)(wsl + WS_NORMW))
#define ROPE  ((float*)(wsl + WS_ROPE))
#define WIN   ((bf16r*)(wsl + WS_WIN))
#define WPA   ((bf16r*)(wsl + WS_WPA))
#define WPB   ((bf16r*)(wsl + WS_WPA) + 2048)
#define WOUT  ((bf16r*)(wsl + WS_WOUT))
#define WGU   ((bf16r*)(wsl + WS_WGU))
#define WDN   ((bf16r*)(wsl + WS_WDN))
#define XN    ((bf16r*)(wsl + WS_XN))
#define OA    ((bf16r*)(wsl + WS_OA))
#define OB    ((bf16r*)(wsl + WS_OB))
#define MG    ((bf16r*)(wsl + WS_MG))
#define OBG   ((bf16r*)(wsl + WS_OBG))
#define LSE   ((float*)(wsl + WS_LSE))
#define KVA   ((bf16r*)(wsl + WS_KVA))
#define A_P     ((bf16r*)(wsl + WS_P))
#define ACT   ((bf16r*)(wsl + WS_P))
    PG8_LAS unsigned char* ring = (PG8_LAS unsigned char*)lds;
    const int wave_s = __builtin_amdgcn_readfirstlane(threadIdx.x >> 6);

    { PH_BEGIN();
        const int gt = blockIdx.x * NTHREADS + tid, NGT = G * NTHREADS;
        for (int i = gt; i < TOK; i += NGT) SUMSQ[i] = 0.f;
        for (int i = gt; i < 3456; i += NGT) XBAR[i] = 0u;
        if (tid < 4) ((LAS unsigned*)(lds + LDS_BYTES - 16))[tid] = 0u;
        for (int i = gt; i < 12 * 129; i += NGT) {
            const int hh = i / 129, jj = i % 129, g = hh >> 2, d = 1 << (2 * g), rel = (jj - 64) * d;
            const int n = rel < 0 ? -rel : rel; const int side = rel > 0 ? 16 : 0;
            const float nf = (float)(n < 1 ? 1 : n);
            int large = 8 + (int)(logf(nf / 8.f) / 4.852030263919617f * 8.f); large = large > 15 ? 15 : large;
            const int bucket = side + (n < 8 ? n : large);
            BTAB[i] = A_rel_bias[bucket * 12 + hh] * (1.0f / att::SCALE);
        }
        for (int i = gt; i < 64 * 32; i += NGT) {
            const int pos = i >> 5, j = i & 31; const float inv = powf(10000.f, -(float)(2 * j) / 64.f); const float ang = (float)pos * inv;
            ROPE[2 * i] = cosf(ang); ROPE[2 * i + 1] = sinf(ang);
        }
        if (gt < 128) { CTRS[gt] = 0u; NORMW[gt] = A_q_norm_a[gt]; NORMW[128 + gt] = A_k_norm_a[gt]; NORMW[256 + gt] = A_q_norm_b[gt]; NORMW[384 + gt] = A_k_norm_b[gt]; }
        LAS float* scr = (LAS float*)(lds) + wave * (64 * 65);
        { DecPlain dec{A_w_in, WIN, INW, DM, C_VA}; NextStatic nx{gw, NGW, 64 * (INW / 64)}; cvt_run(dec, nx, scr, lane); }

        for (int m = gw; m < TOK; m += NGW) {
            const v4f* xr = (const v4f*)(A_x + (size_t)m * DM) + lane; v4f v[16]; float s = 0.f;
#pragma unroll
            for (int j = 0; j < 16; ++j) { v[j] = xr[64 * j]; s += (v[j][0] * v[j][0] + v[j][1] * v[j][1]) + (v[j][2] * v[j][2] + v[j][3] * v[j][3]); }
            const float rstd = 1.0f / sqrtf(wave_sum(s) * (1.0f / DM) + EPS);
            unsigned long long* o8 = (unsigned long long*)(XN + (size_t)m * DM) + lane;
#pragma unroll
            for (int j = 0; j < 16; ++j) { const v4f g = ((const v4f*)A_norm1_g)[lane + 64 * j];
                o8[64 * j] = (unsigned long long)pk2(v[j][0] * rstd * g[0], v[j][1] * rstd * g[1]) | ((unsigned long long)pk2(v[j][2] * rstd * g[2], v[j][3] * rstd * g[3]) << 32); }
        }
    }
    grid.sync();
    const XcdBarrier xbar = xcd_barrier_post((unsigned*)(a.ws + WS_XBAR), (volatile LAS unsigned*)(lds + LDS_BYTES - 16));

    { PH_BEGIN();
        const int NG1 = G;
        if ((int)blockIdx.x < NG1) {
            pg8::Gemm g{XN, WIN, TOK, INW, DM}; pg8::StaticOrder S; S.init(TOK, INW, NG1, (int)blockIdx.x);
            pg8::EpiIn E{A_P, KVA, A_b_gate, NORMW, ROPE, (PG8_LAS float*)(ring + RING_BYTES)};
            pg8::gemm_phase<pg8::EpiIn, pg8::StaticOrder, true, true>(ring, g, S, E, tid);
        }
        { LAS float* scr = (LAS float*)(lds) + wave * (64 * 65);
          { DecPlain dec{A_w_out, WOUT, DM, DM, 0}; NextQueue nx{CTRS + 16, 64 * 64, lane}; cvt_run(dec, nx, scr, lane); }
          { DecPlain dec{A_w_pa, WPA, DM, 2560, 0}; NextQueue nx{CTRS + 32, 32 * 64, lane}; cvt_run(dec, nx, scr, lane); }
          { DecPlain dec{A_w_pb, WPB, DM, 2560, 0}; NextQueue nx{CTRS + 48, 8 * 64, lane}; cvt_run(dec, nx, scr, lane); }
          { DecGU dec{A_w_gate, A_w_up, A_norm2_g, WGU}; NextQueue nx{CTRS + 0, 2 * DecGU::I_G, lane}; cvt_run(dec, nx, scr, lane); } }
    }
    xcd_barrier(xbar);

    { PH_BEGIN();
        for (int u = blockIdx.x; u < BATCH * 16 * 8; u += G) {
            const int qb = u & 7, h = (u >> 3) & 15, b = u >> 7, kvh = h >> 2;
            const att::bf16* Pb = (const att::bf16*)A_P + (size_t)(b * SEQ) * INW;
            const att::bf16* Kc = (const att::bf16*)KVA + ((size_t)(b * 8 + kvh) * SEQ) * 128; const att::bf16* Vc = Kc + (size_t)4 * SEQ * 128;
            att::attn_dense_body<INW, 128, 2560>(Pb + (size_t)(qb * 256) * INW + C_QA + h * 128, Kc, Vc,
                                                 (att::bf16*)OA + (size_t)(b * SEQ + qb * 256) * 2560 + h * 128, SEQ, (char*)lds, tid);
        }
        float* btab = (float*)(lds + RING_BYTES + 2048);
        for (int i = tid; i < 12 * 129; i += NTHREADS) btab[i] = BTAB[i];
        __syncthreads();
        for (int u = gw; u < 3072; u += NGW)
            att::attn_b_unit((const att::bf16*)A_P, (att::bf16*)OBG, LSE, btab, (char*)lds + wave * 16384, (float*)(lds + RING_BYTES) + wave * 64, u, lane);
    }
    xcd_barrier(xbar);

    { PH_BEGIN();
        pg8::StaticOrder S; S.init(TOK, DM, G, (int)blockIdx.x);
        {
            int done_pm = -1;
            for (int ui = 0; ; ++ui) { pg8::Unit uu; if (!S.next(ui, uu)) break; if (uu.pm == done_pm) continue; done_pm = uu.pm;
                const int ch = tid & 63, hh = ch >> 4;
                for (int it0 = 0; it0 < 32; it0 += 8) {
                    float l[8][3]; v4u av[8][3];
#pragma unroll
                    for (int j = 0; j < 8; ++j) { const int row = uu.pm * 256 + (it0 + j) * 8 + (tid >> 6);
#pragma unroll
                        for (int g = 0; g < 3; ++g) { l[j][g] = LSE[((size_t)g * TOK + row) * 4 + hh]; av[j][g] = *(const v4u*)(OBG + ((size_t)g * TOK + row) * 512 + ch * 8); } }
#pragma unroll
                    for (int j = 0; j < 8; ++j) { const int row = uu.pm * 256 + (it0 + j) * 8 + (tid >> 6);
                        const float mx = fmaxf(l[j][0], fmaxf(l[j][1], l[j][2])); float w0 = __expf(l[j][0] - mx), w1 = __expf(l[j][1] - mx), w2 = __expf(l[j][2] - mx); const float inv = 1.0f / (w0 + w1 + w2); w0 *= inv; w1 *= inv; w2 *= inv;
                        pg8::f32x4 x0, x1, y0, y1, z0, z1; pg8::unpack8(av[j][0], x0, x1); pg8::unpack8(av[j][1], y0, y1); pg8::unpack8(av[j][2], z0, z1);
                        *(v4u*)(OA + (size_t)row * 2560 + 2048 + ch * 8) = pg8::pack8(x0 * w0 + y0 * w1 + z0 * w2, x1 * w0 + y1 * w1 + z1 * w2); } } }
            asm volatile("s_waitcnt vmcnt(0)" ::: "memory"); __syncthreads();
        }
        { pg8::Gemm g{OA, WPA, TOK, DM, 2560}; pg8::EpiMerge E{A_P, MG, 32}; pg8::gemm_phase<pg8::EpiMerge, pg8::StaticOrder, true, true>(ring, g, S, E, tid); }
    }
    xcd_barrier(xbar);

    { PH_BEGIN();
        pg8::Gemm g{MG, WOUT, TOK, DM, DM}; pg8::StaticOrder S; S.init(TOK, DM, G, (int)blockIdx.x);
        pg8::EpiOut E{A_x, A_out, XN, SUMSQ};
        pg8::gemm_phase<pg8::EpiOut, pg8::StaticOrder, true, true>(ring, g, S, E, tid);
    }
    xcd_barrier(xbar);

    { PH_BEGIN();
        const int NG6 = G;
        if ((int)blockIdx.x < NG6) {
            pg8::Gemm g{XN, WGU, TOK, NGU, DM}; pg8::StaticOrder S; S.init(TOK, NGU, NG6, (int)blockIdx.x);
            pg8::EpiGU E{SUMSQ, ACT};
            pg8::gemm_phase<pg8::EpiGU, pg8::StaticOrder, true, true>(ring, g, S, E, tid);
        }
        { LAS float* scr = (LAS float*)(lds) + wave * (64 * 65);
          { DecPlain dec{A_w_down, WDN, DM, DFF, 0}; NextQueue nx{CTRS + 64, (DFF / 64) * 64, lane}; cvt_run(dec, nx, scr, lane); } }

    }
    xcd_barrier(xbar);

    { PH_BEGIN();
        pg8::Gemm g{ACT, WDN, TOK, DM, DFF}; pg8::StaticOrder S; S.init(TOK, DM, G, (int)blockIdx.x);
        pg8::EpiDown E{XN, A_out};
        pg8::gemm_phase<pg8::EpiDown, pg8::StaticOrder, true, true>(ring, g, S, E, tid);
    }
}

extern "C" void kernel_launch(void* const* d_in, const int* in_sizes, int n_in, void* d_out, int out_size, void* d_ws, size_t ws_size, hipStream_t stream) {
    static int grid_blocks = 0;
    if (grid_blocks == 0) {
        if (n_in != 16 || in_sizes[0] != TOK * DM || out_size != TOK * DM || ws_size < WS_END) {
            fprintf(stderr, "kernel_launch: unexpected shapes (n_in %d, in0 %d, out %d, ws %zu, need %zu); nothing launched\n", n_in, n_in > 0 ? in_sizes[0] : -1, out_size, ws_size, (size_t)WS_END); grid_blocks = -1; return; }
        int dev = 0, cus = 0, per_cu = 0;
        hipGetDevice(&dev); hipDeviceGetAttribute(&cus, hipDeviceAttributeMultiprocessorCount, dev);
        if (hipFuncSetAttribute((const void*)fwd_megakernel, hipFuncAttributeMaxDynamicSharedMemorySize, LDS_BYTES) != hipSuccess) { fprintf(stderr, "kernel_launch: hipFuncSetAttribute failed\n"); grid_blocks = -1; return; }
        if (hipOccupancyMaxActiveBlocksPerMultiprocessor(&per_cu, (const void*)fwd_megakernel, NTHREADS, LDS_BYTES) != hipSuccess || per_cu < 1) { fprintf(stderr, "kernel_launch: occupancy query gave %d\n", per_cu); per_cu = 1; (void)hipGetLastError(); }
        grid_blocks = cus * per_cu;
    }
    if (grid_blocks < 0) return;
    Args a{};
    for (int i = 0; i < 16; ++i) a.in[i] = (const float*)d_in[i];
    a.out = (float*)d_out; a.ws = (unsigned char*)d_ws;
    void* args[] = {&a};
    hipError_t e = hipLaunchCooperativeKernel((const void*)fwd_megakernel, dim3(grid_blocks), dim3(NTHREADS), args, LDS_BYTES, stream);
    if (e != hipSuccess) fprintf(stderr, "cooperative launch failed: %s (grid %d)\n", hipGetErrorString(e), grid_blocks);
}
```

```cpp
#include <hip/hip_runtime.h>
#include <hip/hip_cooperative_groups.h>
#include <hip/hip_bf16.h>
#include <cstdio>
#include <cstdint>
namespace cg = cooperative_groups;

constexpr int BATCH = 4, SEQ = 2048, TOK = BATCH * SEQ, DM = 4096, INW = 15872, DFF = 11008, NGU = 2 * DFF;
constexpr int C_QA = 0, C_KA = 2048, C_VA = 2560, C_QB = 3072, C_KB = 4608, C_VB = 6144, C_GA = 7680, C_GB = 11776;
constexpr float EPS = 1e-6f;

namespace pg8 {
#define PG8_LAS __attribute__((address_space(3)))
typedef unsigned short bf16_t;
typedef short bf16x8 __attribute__((ext_vector_type(8)));
typedef float f32x4 __attribute__((ext_vector_type(4)));
typedef unsigned u32x4 __attribute__((ext_vector_type(4)));
constexpr int BM = 256, BK = 64, HALF = 128, HTB = HALF * BK * 2  , STAGE_BYTES = 8 * HTB, NXCD = 8, WGM = 8;

__host__ __device__ __forceinline__ int lds_byte(int r, int c) { const int st = (r >> 4) * 2 + (c >> 5), rr = r & 15, cc = c & 31, ob = rr * 64 + cc * 2; return st * 1024 + (ob ^ (((ob >> 9) & 1) << 5)); }
__host__ __device__ __forceinline__ void stage_rc(int b, int& R, int& C) { const int st = b / 1024, sb = b % 1024, swz = sb ^ (((sb >> 9) & 1) << 5); R = (st >> 1) * 16 + swz / 64; C = (st & 1) * 32 + (swz % 64) / 2; }
__host__ __device__ __forceinline__ int perm32(int rho) { const int n = rho >> 4, i = rho & 15; return 8 * (i >> 2) + 4 * n + (i & 3); }

struct Unit { int pm, pn; };
struct Gemm { const bf16_t* A; const bf16_t* Bt; int M, N, K; };

struct StaticOrder {
    int nM, nN, nwg, G, c;
    __host__ __device__ void init(int M, int N, int G_, int c_) { nM = M / BM; nN = N / BM; nwg = nM * nN; G = G_; c = c_; }
    __host__ __device__ bool next(int i, Unit& u) const {
        const long L = (long)i * G + c; if (L >= nwg) return false;
        int wgid = (int)L; { const int q = nwg / NXCD, r = nwg % NXCD, xcd = wgid % NXCD, off = wgid / NXCD; wgid = (xcd < r ? xcd * (q + 1) : r * (q + 1) + (xcd - r) * q) + off; }
        const int nig = WGM * nN, gid = wgid / nig, fm = gid * WGM, gsz = (nM - fm) < WGM ? (nM - fm) : WGM;
        u.pm = fm + ((wgid % nig) % gsz); u.pn = (wgid % nig) / gsz; return true;
    }
    __device__ __forceinline__ void a_ready(const Unit&) const {}
    __device__ __forceinline__ void done(const Unit&) const {}
};

__device__ __forceinline__ unsigned cvt_pk_bf16(float lo, float hi) { unsigned r; asm volatile("v_cvt_pk_bf16_f32 %0, %1, %2" : "=v"(r) : "v"(lo), "v"(hi)); return r; }
__device__ __forceinline__ float sigmoidf_(float x) { return __builtin_amdgcn_rcpf(1.f + __expf(-x)); }
__device__ __forceinline__ float bf_lo(unsigned w) { return __uint_as_float(w << 16); }
__device__ __forceinline__ float bf_hi(unsigned w) { return __uint_as_float(w & 0xffff0000u); }
__device__ __forceinline__ u32x4 pack8(const f32x4 v0, const f32x4 v1) { u32x4 w; w.x = cvt_pk_bf16(v0[0], v0[1]); w.y = cvt_pk_bf16(v0[2], v0[3]); w.z = cvt_pk_bf16(v1[0], v1[1]); w.w = cvt_pk_bf16(v1[2], v1[3]); return w; }
__device__ __forceinline__ void unpack8(const u32x4 w, f32x4& v0, f32x4& v1) { v0 = (f32x4){bf_lo(w.x), bf_hi(w.x), bf_lo(w.y), bf_hi(w.y)}; v1 = (f32x4){bf_lo(w.z), bf_hi(w.z), bf_lo(w.w), bf_hi(w.w)}; }

struct EpiIn {
    static constexpr bool PERM = true, AFTER_DRAIN = false, HOOK = false;
    bf16_t* O; bf16_t* KVA; const float* bgate; const float *normw, *rope; PG8_LAS float* part;
    __device__ __forceinline__ void operator()(const f32x4 (&acc)[2][2][4][2], const Unit& u, int wr, int wc, int fr, int fq) const {
        const int row0 = u.pm * BM + wr * 64 + fr, col0 = u.pn * BM + wc * 32 + 8 * fq;
        const int pn = u.pn;
        const bool gate = (pn >= 30), normed = (pn < 10) || (pn >= 12 && pn < 24), ahead = pn < 10;
        if (normed) {
#pragma unroll
            for (int ai = 0; ai < 2; ++ai)
#pragma unroll
                for (int m = 0; m < 4; ++m)
#pragma unroll
                    for (int bj = 0; bj < 2; ++bj) { const f32x4 v0 = acc[ai][bj][m][0], v1 = acc[ai][bj][m][1];
                        float ss = (v0[0] * v0[0] + v0[1] * v0[1]) + (v0[2] * v0[2] + v0[3] * v0[3]) + (v1[0] * v1[0] + v1[1] * v1[1]) + (v1[2] * v1[2] + v1[3] * v1[3]);
                        ss += __shfl_xor(ss, 16); ss += __shfl_xor(ss, 32);
                        if (fq == 0) part[(ai * HALF + wr * 64 + m * 16 + fr) * 8 + bj * 4 + wc] = ss; }
            asm volatile("s_waitcnt lgkmcnt(0)" ::: "memory"); __builtin_amdgcn_s_barrier(); asm volatile("" ::: "memory");
            const float* wn = normw + (pn < 8 ? 0 : (pn < 10 ? 128 : (pn < 18 ? 256 : 384)));
            const int half = wc >> 1, qq = (wc & 1) * 4 + fq;
            const f32x4 w0 = ahead ? *(const f32x4*)(wn + half * 64 + 4 * qq) : *(const f32x4*)(wn + wc * 32 + 8 * fq);
            const f32x4 w1 = ahead ? *(const f32x4*)(wn + half * 64 + 32 + 4 * qq) : *(const f32x4*)(wn + wc * 32 + 8 * fq + 4);
#pragma unroll
            for (int ai = 0; ai < 2; ++ai)
#pragma unroll
                for (int m = 0; m < 4; ++m) { const int rl = ai * HALF + wr * 64 + m * 16 + fr, row = u.pm * BM + rl; bf16_t* rowp = O + (size_t)row * INW + col0;
                    f32x4 cs0 = {1.f, 0.f, 1.f, 0.f}, cs1 = {1.f, 0.f, 1.f, 0.f};
                    if (ahead) { const int t = row & (SEQ - 1), pos = half ? (t & 63) : (t >> 6); const float* rt = rope + ((size_t)pos * 32 + 4 * qq) * 2; cs0 = *(const f32x4*)rt; cs1 = *(const f32x4*)(rt + 4); }
#pragma unroll
                    for (int bj = 0; bj < 2; ++bj) { const f32x4 p4 = *(const PG8_LAS f32x4*)(part + rl * 8 + bj * 4);
                        const float rstd = __builtin_amdgcn_rsqf(((p4[0] + p4[1]) + (p4[2] + p4[3])) * (1.0f / 128.f) + EPS);
                        f32x4 v0 = acc[ai][bj][m][0] * rstd * w0, v1 = acc[ai][bj][m][1] * rstd * w1;
                        if (ahead) { const f32x4 c = {cs0[0], cs0[2], cs1[0], cs1[2]}, sn = {cs0[1], cs0[3], cs1[1], cs1[3]};
                            const f32x4 lo = v0 * c - v1 * sn, hi = v1 * c + v0 * sn; v0 = lo; v1 = hi; }
                        bf16_t* dst = (pn >= 8 && pn < 12) ? KVA + (((size_t)(row >> 11) * 8 + (pn - 8) * 2 + bj) * SEQ + (row & (SEQ - 1))) * 128 + wc * 32 + 8 * fq : rowp + bj * HALF;
                        *(u32x4*)dst = pack8(v0, v1); } }
            return;
        }
        f32x4 bv[2][2];
#pragma unroll
        for (int bj = 0; bj < 2; ++bj)
#pragma unroll
            for (int n = 0; n < 2; ++n) bv[bj][n] = gate ? *(const f32x4*)(bgate + (col0 - C_GA) + bj * HALF + 4 * n) : (f32x4){0.f, 0.f, 0.f, 0.f};
#pragma unroll
        for (int ai = 0; ai < 2; ++ai)
#pragma unroll
            for (int m = 0; m < 4; ++m) { const int row = row0 + ai * HALF + m * 16; bf16_t* rowp = O + (size_t)row * INW + col0;
#pragma unroll
                for (int bj = 0; bj < 2; ++bj) { f32x4 v0 = acc[ai][bj][m][0], v1 = acc[ai][bj][m][1];
                    if (gate) { v0 += bv[bj][0]; v1 += bv[bj][1];
#pragma unroll
                        for (int e = 0; e < 4; ++e) { v0[e] = sigmoidf_(v0[e]); v1[e] = sigmoidf_(v1[e]); } }
                    bf16_t* dst = (pn >= 8 && pn < 12) ? KVA + (((size_t)(row >> 11) * 8 + (pn - 8) * 2 + bj) * SEQ + (row & (SEQ - 1))) * 128 + wc * 32 + 8 * fq : rowp + bj * HALF;
                    *(u32x4*)dst = pack8(v0, v1); } }
    }
};
struct EpiMerge {
    static constexpr bool PERM = true, AFTER_DRAIN = false, HOOK = true;
    const bf16_t* P; bf16_t* MG; int hook_t;
    __device__ __forceinline__ void hook(f32x4 (&acc)[2][2][4][2], const Unit& u, int wr, int wc, int fr, int fq) const {
        int row0 = u.pm * BM + wr * 64 + fr, col0 = u.pn * BM + wc * 32 + 8 * fq;
        asm volatile("" : "+v"(row0), "+v"(col0));
#pragma unroll
        for (int ai = 0; ai < 2; ++ai)
#pragma unroll
            for (int m = 0; m < 4; ++m) { const size_t row = (size_t)(row0 + ai * HALF + m * 16);
#pragma unroll
                for (int bj = 0; bj < 2; ++bj) { const int col = col0 + bj * HALF;
                    f32x4 a0, a1, b0, b1; unpack8(*(const u32x4*)(P + row * INW + C_GA + col), a0, a1); unpack8(*(const u32x4*)(P + row * INW + C_GB + col), b0, b1);
#pragma unroll
                    for (int e = 0; e < 4; ++e) { acc[ai][bj][m][0][e] *= a0[e] * __builtin_amdgcn_rcpf(fmaxf(b0[e], 1e-30f)); acc[ai][bj][m][1][e] *= a1[e] * __builtin_amdgcn_rcpf(fmaxf(b1[e], 1e-30f)); }
                    asm volatile("" ::: "memory"); } }
    }
    __device__ __forceinline__ void operator()(const f32x4 (&acc)[2][2][4][2], const Unit& u, int wr, int wc, int fr, int fq) const {
        const int row0 = u.pm * BM + wr * 64 + fr, col0 = u.pn * BM + wc * 32 + 8 * fq;
#pragma unroll
        for (int ai = 0; ai < 2; ++ai)
#pragma unroll
            for (int m = 0; m < 4; ++m) { const size_t row = (size_t)(row0 + ai * HALF + m * 16);
#pragma unroll
                for (int bj = 0; bj < 2; ++bj) { const int col = col0 + bj * HALF;
                    f32x4 g0, g1; unpack8(*(const u32x4*)(P + row * INW + C_GB + col), g0, g1);
                    *(u32x4*)(MG + row * DM + col) = pack8(acc[ai][bj][m][0] * g0, acc[ai][bj][m][1] * g1); } }
    }
};
struct EpiOut {
    static constexpr bool PERM = true, AFTER_DRAIN = false, HOOK = false;
    const float* x; float* out; bf16_t* XB; float* sumsq;
    __device__ __forceinline__ void operator()(const f32x4 (&acc)[2][2][4][2], const Unit& u, int wr, int wc, int fr, int fq) const {
        const int row0 = u.pm * BM + wr * 64 + fr, col0 = u.pn * BM + wc * 32 + 8 * fq;
#pragma unroll
        for (int ai = 0; ai < 2; ++ai)
#pragma unroll
            for (int m = 0; m < 4; ++m) { const size_t row = (size_t)(row0 + ai * HALF + m * 16); float ss = 0.f;
#pragma unroll
                for (int bj = 0; bj < 2; ++bj) { const int col = col0 + bj * HALF;
                    const f32x4 v0 = acc[ai][bj][m][0] + *(const f32x4*)(x + row * DM + col), v1 = acc[ai][bj][m][1] + *(const f32x4*)(x + row * DM + col + 4);
                    *(u32x4*)(XB + row * DM + col) = pack8(v0, v1);
                    ss += (v0[0] * v0[0] + v0[1] * v0[1]) + (v0[2] * v0[2] + v0[3] * v0[3]) + (v1[0] * v1[0] + v1[1] * v1[1]) + (v1[2] * v1[2] + v1[3] * v1[3]); }
                ss += __shfl_xor(ss, 16); ss += __shfl_xor(ss, 32);
                if (fq == 0) atomicAdd(sumsq + row, ss); }
    }
};
struct EpiGU {
    static constexpr bool PERM = true, AFTER_DRAIN = false, HOOK = false;
    const float* sumsq; bf16_t* ACT;
    __device__ __forceinline__ void operator()(const f32x4 (&acc)[2][2][4][2], const Unit& u, int wr, int wc, int fr, int fq) const {
        const int row0 = u.pm * BM + wr * 64 + fr, col0 = u.pn * HALF + wc * 32 + 8 * fq;
#pragma unroll
        for (int ai = 0; ai < 2; ++ai)
#pragma unroll
            for (int m = 0; m < 4; ++m) { const size_t row = (size_t)(row0 + ai * HALF + m * 16);
                const float rstd = __builtin_amdgcn_rsqf(sumsq[row] * (1.0f / DM) + EPS);
                f32x4 o[2];
#pragma unroll
                for (int n = 0; n < 2; ++n)
#pragma unroll
                    for (int e = 0; e < 4; ++e) { const float g = acc[ai][0][m][n][e] * rstd, uu = acc[ai][1][m][n][e] * rstd; o[n][e] = g * sigmoidf_(g) * uu; }
                *(u32x4*)(ACT + row * DFF + col0) = pack8(o[0], o[1]); }
    }
};
struct EpiDown {
    static constexpr bool PERM = true, AFTER_DRAIN = false, HOOK = false;
    const bf16_t* XB; float* out;
    __device__ __forceinline__ void operator()(const f32x4 (&acc)[2][2][4][2], const Unit& u, int wr, int wc, int fr, int fq) const {
        const int row0 = u.pm * BM + wr * 64 + fr, col0 = u.pn * BM + wc * 32 + 8 * fq;
#pragma unroll
        for (int ai = 0; ai < 2; ++ai)
#pragma unroll
            for (int m = 0; m < 4; ++m) { const size_t row = (size_t)(row0 + ai * HALF + m * 16);
#pragma unroll
                for (int bj = 0; bj < 2; ++bj) { const size_t off = row * DM + col0 + bj * HALF;
                    f32x4 a0, a1; unpack8(*(const u32x4*)(XB + off), a0, a1);
                    *(f32x4*)(out + off) = a0 + acc[ai][bj][m][0]; *(f32x4*)(out + off + 4) = a1 + acc[ai][bj][m][1]; } }
    }
};
template <class Epi, class Sched, bool ALIGN_EPI = false, bool SP2 = false>
__device__ __forceinline__ void gemm_phase(PG8_LAS unsigned char* lds, const Gemm g, const Sched& S, const Epi& E, int tid_l) {
    const int tid = tid_l, wid = __builtin_amdgcn_readfirstlane(tid >> 6), lane = tid & 63, wr = wid >> 2, wc = wid & 3, fr = lane & 15, fq = lane >> 4;
    const int K = g.K, nt = K / BK;
    unsigned voffA[2], voffB[2];
#pragma unroll
    for (int i = 0; i < 2; ++i) { int R, C; stage_rc(tid * 16 + i * 8192, R, C); const int Rb = Epi::PERM ? ((R & ~31) + perm32(R & 31)) : R;
        voffA[i] = (unsigned)(R * K + C) * 2u; voffB[i] = (unsigned)(Rb * K + C) * 2u; }
    const size_t kstep = (size_t)(BK * 2);
    const size_t hstep = (size_t)HALF * K * 2;
    const size_t tstep = 2 * hstep;
    const unsigned ldsw = (unsigned)wid * 1024u;
    const int aoff = lds_byte(wr * 64 + fr, fq * 8), boff = lds_byte(wc * 32 + fr, fq * 8);
#define PG8_SA(b, h) (((b) * 2 + (h)) * HTB)
#define PG8_SB(b, h) ((4 + (b) * 2 + (h)) * HTB)
#define PG8_STAGE(bufoff, gbase, voff) do { _Pragma("unroll") for (int _i = 0; _i < 2; ++_i) \
        __builtin_amdgcn_global_load_lds((const unsigned*)((const char*)(gbase) + (voff)[_i]), (PG8_LAS unsigned*)(lds + (bufoff) + ldsw + _i * 8192), 16, 0, 0); } while (0)
#define PG8_LDA(dst, b, h) do { _Pragma("unroll") for (int m = 0; m < 4; ++m) _Pragma("unroll") for (int k = 0; k < 2; ++k) dst[m][k] = *(const PG8_LAS bf16x8*)(lds + PG8_SA(b, h) + aoff + m * 2048 + k * 1024); } while (0)
#define PG8_LDB(dst, b, h) do { _Pragma("unroll") for (int n = 0; n < 2; ++n) _Pragma("unroll") for (int k = 0; k < 2; ++k) dst[n][k] = *(const PG8_LAS bf16x8*)(lds + PG8_SB(b, h) + boff + n * 2048 + k * 1024); } while (0)
#define PG8_MMA(ai, bj, At, Bt) do { __builtin_amdgcn_s_setprio(1); _Pragma("unroll") for (int m = 0; m < 4; ++m) _Pragma("unroll") for (int n = 0; n < 2; ++n) _Pragma("unroll") for (int k = 0; k < 2; ++k) \
        acc[ai][bj][m][n] = __builtin_amdgcn_mfma_f32_16x16x32_bf16(Bt[n][k], At[m][k], acc[ai][bj][m][n], 0, 0, 0); __builtin_amdgcn_s_setprio(0); } while (0)
#define PG8_WAIT_V(n) asm volatile("s_waitcnt vmcnt(" #n ")" ::: "memory")
#define PG8_WAIT_L(n) asm volatile("s_waitcnt lgkmcnt(" #n ")" ::: "memory")
#define PG8_BAR __builtin_amdgcn_s_barrier()
#define PG8_SCHED __builtin_amdgcn_sched_barrier(0)
    Unit cur, nxt; int ui = 0;
    if (!S.next(0, cur)) return;
    f32x4 acc[2][2][4][2];
#pragma unroll
    for (int a = 0; a < 2; ++a)
#pragma unroll
        for (int b = 0; b < 2; ++b)
#pragma unroll
            for (int m = 0; m < 4; ++m)
#pragma unroll
                for (int n = 0; n < 2; ++n) acc[a][b][m][n] = (f32x4){0.f, 0.f, 0.f, 0.f};
    bf16x8 At[4][2], B0[2][2], B1[2][2];
    const char* cA = (const char*)g.A + (size_t)cur.pm * tstep; const char* cB = (const char*)g.Bt + (size_t)cur.pn * tstep;
    S.a_ready(cur);
    if constexpr (SP2) {
        PG8_STAGE(PG8_SB(0, 0), cB, voffB); PG8_STAGE(PG8_SB(0, 1), cB + hstep, voffB); PG8_STAGE(PG8_SA(0, 0), cA, voffA); PG8_STAGE(PG8_SA(0, 1), cA + hstep, voffA);
        if (wr == 1) PG8_BAR;
        PG8_WAIT_V(2); PG8_BAR;
        PG8_STAGE(PG8_SB(1, 0), cB + kstep, voffB); PG8_STAGE(PG8_SA(1, 0), cA + kstep, voffA); PG8_STAGE(PG8_SB(1, 1), cB + hstep + kstep, voffB);
        PG8_WAIT_V(6); PG8_BAR;
    } else {
        PG8_STAGE(PG8_SB(0, 0), cB, voffB); PG8_STAGE(PG8_SA(0, 0), cA, voffA); PG8_STAGE(PG8_SB(0, 1), cB + hstep, voffB); PG8_STAGE(PG8_SA(0, 1), cA + hstep, voffA);
        if (wr == 1) PG8_BAR;
        PG8_WAIT_V(4); PG8_BAR;
        PG8_STAGE(PG8_SB(1, 0), cB + kstep, voffB); PG8_STAGE(PG8_SA(1, 0), cA + kstep, voffA); PG8_STAGE(PG8_SB(1, 1), cB + hstep + kstep, voffB);
        PG8_WAIT_V(6); PG8_BAR;
    }
    for (;;) {
        const bool has_next = S.next(ui + 1, nxt);
        const char* nA = has_next ? (const char*)g.A + (size_t)nxt.pm * tstep : cA; const char* nB = has_next ? (const char*)g.Bt + (size_t)nxt.pn * tstep : cB;
        for (int t = 0; t < nt; t += 2) {
            if constexpr (Epi::HOOK) { if (t == E.hook_t) E.hook(acc, cur, wr, wc, fr, fq); }
            const bool last = (t == nt - 2);
            const char* a1 = cA + (size_t)(t + 1) * kstep;
            const char* a2 = last ? nA : cA + (size_t)(t + 2) * kstep; const char* b2 = last ? nB : cB + (size_t)(t + 2) * kstep;
            const char* a3 = a2 + kstep; const char* b3 = b2 + kstep;
            if (last && has_next) S.a_ready(nxt);
            if constexpr (SP2) {
            PG8_LDB(B0, 0, 0); PG8_LDB(B1, 0, 1); PG8_SCHED; PG8_LDA(At, 0, 0); PG8_STAGE(PG8_SA(1, 1), a1 + hstep, voffA);
            PG8_WAIT_V(8); PG8_WAIT_L(0); PG8_BAR; PG8_MMA(0, 0, At, B0); PG8_MMA(0, 1, At, B1); PG8_BAR; PG8_SCHED;
            PG8_LDA(At, 0, 1); PG8_STAGE(PG8_SB(0, 0), b2, voffB); PG8_STAGE(PG8_SB(0, 1), b2 + hstep, voffB); PG8_STAGE(PG8_SA(0, 0), a2, voffA);
            PG8_WAIT_V(8); PG8_WAIT_L(0); PG8_BAR; PG8_MMA(1, 0, At, B0); PG8_MMA(1, 1, At, B1); PG8_BAR; PG8_SCHED;
            PG8_LDB(B0, 1, 0); PG8_LDB(B1, 1, 1); PG8_SCHED; PG8_LDA(At, 1, 0); PG8_STAGE(PG8_SA(0, 1), a2 + hstep, voffA);
            PG8_WAIT_V(8); PG8_WAIT_L(0); PG8_BAR; PG8_MMA(0, 0, At, B0); PG8_MMA(0, 1, At, B1); PG8_BAR; PG8_SCHED;
            PG8_LDA(At, 1, 1); PG8_STAGE(PG8_SB(1, 0), b3, voffB); PG8_STAGE(PG8_SB(1, 1), b3 + hstep, voffB); PG8_STAGE(PG8_SA(1, 0), a3, voffA);
            PG8_WAIT_V(8); PG8_WAIT_L(0); PG8_BAR; PG8_MMA(1, 0, At, B0); PG8_MMA(1, 1, At, B1); PG8_BAR; PG8_SCHED;
            } else {
            PG8_LDB(B0, 0, 0); PG8_SCHED; PG8_LDA(At, 0, 0); PG8_STAGE(PG8_SA(1, 1), a1 + hstep, voffA);
            PG8_WAIT_L(8); PG8_BAR; PG8_WAIT_L(0); PG8_MMA(0, 0, At, B0); PG8_BAR; PG8_SCHED;
            PG8_LDB(B1, 0, 1); PG8_STAGE(PG8_SB(0, 0), b2, voffB);
            PG8_BAR; PG8_WAIT_L(0); PG8_MMA(0, 1, At, B1); PG8_BAR;
            PG8_LDA(At, 0, 1); PG8_STAGE(PG8_SA(0, 0), a2, voffA);
            PG8_BAR; PG8_WAIT_L(0); PG8_MMA(1, 0, At, B0); PG8_BAR; PG8_SCHED;
            PG8_STAGE(PG8_SB(0, 1), b2 + hstep, voffB);
            PG8_WAIT_V(6); PG8_BAR; PG8_MMA(1, 1, At, B1); PG8_BAR;
            PG8_LDB(B0, 1, 0); PG8_SCHED; PG8_LDA(At, 1, 0); PG8_STAGE(PG8_SA(0, 1), a2 + hstep, voffA);
            PG8_WAIT_L(8); PG8_BAR; PG8_WAIT_L(0); PG8_MMA(0, 0, At, B0); PG8_BAR; PG8_SCHED;
            PG8_LDB(B1, 1, 1); PG8_STAGE(PG8_SB(1, 0), b3, voffB);
            PG8_BAR; PG8_WAIT_L(0); PG8_MMA(0, 1, At, B1); PG8_BAR;
            PG8_LDA(At, 1, 1); PG8_STAGE(PG8_SA(1, 0), a3, voffA);
            PG8_BAR; PG8_WAIT_L(0); PG8_MMA(1, 0, At, B0); PG8_BAR; PG8_SCHED;
            PG8_STAGE(PG8_SB(1, 1), b3 + hstep, voffB);
            PG8_WAIT_V(6); PG8_BAR; PG8_MMA(1, 1, At, B1); PG8_BAR;
            }
        }
        if constexpr (ALIGN_EPI) { if (wr == 0) PG8_BAR; }
        if constexpr (!Epi::AFTER_DRAIN) { E(acc, cur, wr, wc, fr, fq); S.done(cur); }
        if (!has_next) break;
#pragma unroll
        for (int a = 0; a < 2; ++a)
#pragma unroll
            for (int b = 0; b < 2; ++b)
#pragma unroll
                for (int m = 0; m < 4; ++m)
#pragma unroll
                    for (int n = 0; n < 2; ++n) acc[a][b][m][n] = (f32x4){0.f, 0.f, 0.f, 0.f};
        cur = nxt; cA = nA; cB = nB; ++ui;
        if constexpr (ALIGN_EPI) { if (wr == 1) PG8_BAR; }
    }
    PG8_WAIT_V(0);
    if constexpr (!ALIGN_EPI) { if (wr == 0) PG8_BAR; }
    PG8_BAR;
    if constexpr (Epi::AFTER_DRAIN) { E.fused(acc, cur, wr, wc, fr, fq, lds, wid, lane); S.done(cur); }
#undef PG8_SA
#undef PG8_SB
#undef PG8_STAGE
#undef PG8_LDA
#undef PG8_LDB
#undef PG8_MMA
#undef PG8_WAIT_V
#undef PG8_WAIT_L
#undef PG8_BAR
#undef PG8_SCHED
}
}
namespace att {
using bf16 = __hip_bfloat16;
constexpr int D = 128, NW = 8, QBLK = 32, KVBLK = 64;
constexpr float SCALE = 0.088388347648318440f;
constexpr float THR = 8.f;
constexpr int SDEPTH = 2;
constexpr size_t SHM_V = KVBLK * D * 2, SHM_K = KVBLK * D * 2, SHM_ATTN = 2 * SHM_V + 2 * SHM_K + NW * 64 * 4;
using bf16x8 = __attribute__((ext_vector_type(8))) short;
using s16x4  = __attribute__((ext_vector_type(4))) short;
using f32x16 = __attribute__((ext_vector_type(16))) float;
using f32x8  = __attribute__((ext_vector_type(8))) float;
using u32x4  = __attribute__((ext_vector_type(4))) unsigned;
#define KSWZ(row, colB) ((row) * 256 + ((colB) ^ (((row) & 7) << 4)))
#define SBAR() __builtin_amdgcn_sched_barrier(0)
__device__ __forceinline__ int crow(int r, int hi) { return (r & 3) + 8 * (r >> 2) + 4 * hi; }
__device__ __forceinline__ unsigned cvtpk(float lo, float hi) {
  unsigned r; asm volatile("v_cvt_pk_bf16_f32 %0, %1, %2" : "=v"(r) : "v"(lo), "v"(hi)); return r;
}
template <typename TIn> struct Stage;
template <> struct Stage<bf16>  { using T = bf16x8;
  __device__ static __forceinline__ T ld8(const bf16* p) { return *reinterpret_cast<const bf16x8*>(p); }
  __device__ static __forceinline__ bf16x8 tobf(T x) { return x; } };
template <> struct Stage<float> { using T = f32x8;
  __device__ static __forceinline__ T ld8(const float* p) { return *reinterpret_cast<const f32x8*>(p); }
  __device__ static __forceinline__ bf16x8 tobf(T x) {
    u32x4 w = {cvtpk(x[0], x[1]), cvtpk(x[2], x[3]), cvtpk(x[4], x[5]), cvtpk(x[6], x[7])}; return *reinterpret_cast<bf16x8*>(&w); } };

__device__ __forceinline__ void partialSM(f32x16& p0, f32x16& p1, float& m_reg, float& mn, float& alpha) {
  constexpr float C = SCALE * 1.4426950408889634f;
  float pmax = p0[0]; for (int r = 1; r < 16; ++r) pmax = fmaxf(pmax, p0[r]); for (int r = 0; r < 16; ++r) pmax = fmaxf(pmax, p1[r]);
  { auto rr = __builtin_amdgcn_permlane32_swap(__float_as_uint(pmax), __float_as_uint(pmax), false, false);
    pmax = fmaxf(__uint_as_float(rr[0]), __uint_as_float(rr[1])); }
  if (__builtin_expect(__all(pmax - m_reg <= THR / SCALE), 1)) { mn = m_reg; alpha = 1.f; }
  else { mn = fmaxf(m_reg, pmax); alpha = __builtin_amdgcn_exp2f((m_reg - mn) * C); m_reg = mn; }
  float mnC = -mn * C;
  for (int r = 0; r < 16; ++r) p0[r] = fmaf(p0[r], C, mnC); for (int r = 0; r < 16; ++r) p1[r] = fmaf(p1[r], C, mnC);
  for (int r = 0; r < 16; ++r) p0[r] = __builtin_amdgcn_exp2f(p0[r]);
}
__device__ __forceinline__ void finishSM(f32x16& p0, f32x16& p1, float alpha, float& l_reg, bf16x8& pa0, bf16x8& pa1, bf16x8& pa2, bf16x8& pa3) {
  for (int r = 0; r < 16; ++r) p1[r] = __builtin_amdgcn_exp2f(p1[r]);
  float ps = 0; for (int r = 0; r < 16; ++r) ps += p0[r]; for (int r = 0; r < 16; ++r) ps += p1[r];
  { auto rr = __builtin_amdgcn_permlane32_swap(__float_as_uint(ps), __float_as_uint(ps), false, false);
    ps = __uint_as_float(rr[0]) + __uint_as_float(rr[1]); }
  l_reg = l_reg * alpha + ps;
#define PK4(P, BASE, OUT) do { unsigned a0 = cvtpk(P[BASE + 0], P[BASE + 1]), a1 = cvtpk(P[BASE + 2], P[BASE + 3]);   \
    unsigned b0 = cvtpk(P[BASE + 4], P[BASE + 5]), b1 = cvtpk(P[BASE + 6], P[BASE + 7]);                              \
    auto r0 = __builtin_amdgcn_permlane32_swap(a0, b0, false, false); auto r1 = __builtin_amdgcn_permlane32_swap(a1, b1, false, false); \
    u32x4 w = {r0[0], r1[0], r0[1], r1[1]}; OUT = *reinterpret_cast<bf16x8*>(&w); } while (0)
  PK4(p0, 0, pa0); PK4(p0, 8, pa1); PK4(p1, 0, pa2); PK4(p1, 8, pa3);
#undef PK4
}
__device__ __forceinline__ void qkt(f32x16& p0, f32x16& p1, const bf16* Ks, const bf16x8* qr, int r32, int hi) {
  p0 = f32x16{}; p1 = f32x16{};
  for (int d0 = 0; d0 < 8; ++d0) { int cb = (d0 * 16 + hi * 8) * 2;
    bf16x8 b0 = *reinterpret_cast<const bf16x8*>((const char*)Ks + KSWZ(r32, cb));
    bf16x8 b1 = *reinterpret_cast<const bf16x8*>((const char*)Ks + KSWZ(32 + r32, cb));
    p0 = __builtin_amdgcn_mfma_f32_32x32x16_bf16(b0, qr[d0], p0, 0, 0, 0);
    p1 = __builtin_amdgcn_mfma_f32_32x32x16_bf16(b1, qr[d0], p1, 0, 0, 0); }
}
__device__ __forceinline__ int v_st(int k, int c) { const int kk = (k & ~0xC) | ((k & 4) << 1) | ((k & 8) >> 1); return ((kk >> 3) * 4 + (c >> 5)) * 512 + ((kk & 7) * 32 + (c & 31)) * 2; }
__device__ __forceinline__ int v_rd_base(int lane) { return ((lane & 3) << 3) | (((lane >> 2) & 3) << 6) | (((lane >> 4) & 1) << 5) | (((lane >> 5) & 1) << 8); }
constexpr int v_rd_off(int d0, int ks, int half) { return d0 * 512 + ks * 4096 + half * 2048; }
template <int OFF> __device__ __forceinline__ s16x4 tr_read(int vb) {
  s16x4 r; asm volatile("ds_read_b64_tr_b16 %0, %1 offset:%2" : "=&v"(r) : "v"(vb), "i"(OFF) : "memory"); return r;
}
template <int D0> __device__ __forceinline__ void pv_one(f32x16& od, int vb, bf16x8 pa0, bf16x8 pa1, bf16x8 pa2, bf16x8 pa3) {
  const s16x4 l0 = tr_read<v_rd_off(D0, 0, 0)>(vb), h0 = tr_read<v_rd_off(D0, 0, 1)>(vb), l1 = tr_read<v_rd_off(D0, 1, 0)>(vb), h1 = tr_read<v_rd_off(D0, 1, 1)>(vb);
  const s16x4 l2 = tr_read<v_rd_off(D0, 2, 0)>(vb), h2 = tr_read<v_rd_off(D0, 2, 1)>(vb), l3 = tr_read<v_rd_off(D0, 3, 0)>(vb), h3 = tr_read<v_rd_off(D0, 3, 1)>(vb);
  asm volatile("s_waitcnt lgkmcnt(0)" ::: "memory"); SBAR();
#define PK(L, H) (bf16x8){L[0], L[1], L[2], L[3], H[0], H[1], H[2], H[3]}
  od = __builtin_amdgcn_mfma_f32_32x32x16_bf16(pa0, PK(l0, h0), od, 0, 0, 0);
  od = __builtin_amdgcn_mfma_f32_32x32x16_bf16(pa1, PK(l1, h1), od, 0, 0, 0);
  od = __builtin_amdgcn_mfma_f32_32x32x16_bf16(pa2, PK(l2, h2), od, 0, 0, 0);
  od = __builtin_amdgcn_mfma_f32_32x32x16_bf16(pa3, PK(l3, h3), od, 0, 0, 0);
#undef PK
}
__device__ __forceinline__ void pv_d0(f32x16* o, int vb, bf16x8 pa0, bf16x8 pa1, bf16x8 pa2, bf16x8 pa3) {
  pv_one<0>(o[0], vb, pa0, pa1, pa2, pa3); pv_one<1>(o[1], vb, pa0, pa1, pa2, pa3); pv_one<2>(o[2], vb, pa0, pa1, pa2, pa3); pv_one<3>(o[3], vb, pa0, pa1, pa2, pa3);
}

template <int LDQ, int LDK, int LDO>
__device__ __forceinline__ void attn_dense_body(const bf16* __restrict__ Qb, const bf16* __restrict__ Kh, const bf16* __restrict__ Vh,
                                                bf16* __restrict__ Ob, int seq, char* lds, int tid_l) {
  using St = Stage<bf16>;
  const int tid = tid_l, wid = tid >> 6, lane = tid & 63, r32 = lane & 31, hi = lane >> 5;
  bf16* V_lds = (bf16*)lds; bf16* K_lds = (bf16*)(lds + 2 * SHM_V);
  float* ws = (float*)(lds + 2 * SHM_V + 2 * SHM_K) + wid * 64; float* li_l = ws; float* al_l = ws + 32;
  float m_reg = -1e30f, l_reg = 0; f32x16 o[4] = {}; bf16x8 qr[8];
  const bf16* Qw = Qb + (long)(wid * QBLK + r32) * LDQ + hi * 8;
#pragma unroll
  for (int d0 = 0; d0 < 8; ++d0) qr[d0] = St::ld8(Qw + d0 * 16);
  const int sr = tid >> 4, sc = (tid & 15) * 8, vst0 = v_st(sr, sc), vst1 = v_st(32 + sr, sc);
  const int vb0 = (int)(uintptr_t)V_lds + v_rd_base(lane);
  struct { typename St::T vs0, vs1, ks0, ks1; } sr_[SDEPTH];
#define SLOAD(i, k0) do { sr_[i].vs0 = St::ld8(&Vh[(long)((k0) + sr) * LDK + sc]); sr_[i].vs1 = St::ld8(&Vh[(long)((k0) + 32 + sr) * LDK + sc]); \
    sr_[i].ks0 = St::ld8(&Kh[(long)((k0) + sr) * LDK + sc]); sr_[i].ks1 = St::ld8(&Kh[(long)((k0) + 32 + sr) * LDK + sc]); } while (0)
#define SWRITE(b, i) do { *(bf16x8*)((char*)V_lds + (b) * SHM_V + vst0) = St::tobf(sr_[i].vs0);          \
    *(bf16x8*)((char*)V_lds + (b) * SHM_V + vst1) = St::tobf(sr_[i].vs1); int kc = sc * 2;               \
    *(bf16x8*)((char*)K_lds + (b) * SHM_K + KSWZ(sr, kc)) = St::tobf(sr_[i].ks0);                       \
    *(bf16x8*)((char*)K_lds + (b) * SHM_K + KSWZ(32 + sr, kc)) = St::tobf(sr_[i].ks1); } while (0)
#define SWAIT() do { if constexpr (SDEPTH == 2) asm volatile("s_waitcnt vmcnt(4)" ::: "memory"); else asm volatile("s_waitcnt vmcnt(0)" ::: "memory"); } while (0)
#define RESC(a) do { if (__any((a) < 1.f)) { if (hi == 0) al_l[r32] = (a); asm volatile("s_waitcnt lgkmcnt(0)" ::: "memory"); \
    for (int d = 0; d < 4; ++d) for (int r = 0; r < 16; ++r) o[d][r] *= al_l[crow(r, hi)]; } } while (0)
  f32x16 pA0, pA1, pB0, pB1; float mnA, mnB, alA, alB; bf16x8 pa0, pa1, pa2, pa3; const int NT = seq / KVBLK;
  constexpr int SE = 0, SO = SDEPTH - 1;
  SLOAD(SE, 0); asm volatile("s_waitcnt vmcnt(0)" ::: "memory"); SWRITE(0, SE); __syncthreads();
  qkt(pA0, pA1, K_lds, qr, r32, hi); partialSM(pA0, pA1, m_reg, mnA, alA);
  SLOAD(SO, KVBLK); if constexpr (SDEPTH == 2) { if (2 < NT) SLOAD(SE, 2 * KVBLK); }
  SWAIT(); SWRITE(1, SO); __syncthreads();
  for (int j = 1; j + 1 < NT; j += 2) {
    SBAR(); qkt(pB0, pB1, (bf16*)((char*)K_lds + SHM_K), qr, r32, hi);
    finishSM(pA0, pA1, alA, l_reg, pa0, pa1, pa2, pa3); SBAR();
    SLOAD(SO, (j + SDEPTH) * KVBLK); SBAR();
    pv_d0(o, vb0, pa0, pa1, pa2, pa3); partialSM(pB0, pB1, m_reg, mnB, alB);
    __syncthreads(); SWAIT(); SWRITE(0, SE);
    RESC(alB); __syncthreads();
    SBAR(); qkt(pA0, pA1, K_lds, qr, r32, hi);
    finishSM(pB0, pB1, alB, l_reg, pa0, pa1, pa2, pa3); SBAR();
    if (SDEPTH == 1 || j + 3 < NT) SLOAD(SE, (j + 1 + SDEPTH) * KVBLK); SBAR();
    pv_d0(o, vb0 + (int)SHM_V, pa0, pa1, pa2, pa3); partialSM(pA0, pA1, m_reg, mnA, alA);
    __syncthreads(); SWAIT(); SWRITE(1, SO);
    RESC(alA); __syncthreads();
  }
  SBAR(); qkt(pB0, pB1, (bf16*)((char*)K_lds + SHM_K), qr, r32, hi);
  finishSM(pA0, pA1, alA, l_reg, pa0, pa1, pa2, pa3); SBAR();
  pv_d0(o, vb0, pa0, pa1, pa2, pa3); partialSM(pB0, pB1, m_reg, mnB, alB);
  __syncthreads(); RESC(alB);
  finishSM(pB0, pB1, alB, l_reg, pa0, pa1, pa2, pa3); SBAR();
  pv_d0(o, vb0 + (int)SHM_V, pa0, pa1, pa2, pa3);
  if (hi == 0) li_l[r32] = l_reg; asm volatile("s_waitcnt lgkmcnt(0)" ::: "memory");
  float rli[16];
#pragma unroll
  for (int r = 0; r < 16; ++r) rli[r] = __builtin_amdgcn_rcpf(li_l[crow(r, hi)]);
  bf16* Ow = Ob + (long)(wid * QBLK) * LDO;
#pragma unroll
  for (int r = 0; r < 16; ++r) { int orow = crow(r, hi);
    for (int d0 = 0; d0 < 4; ++d0) Ow[(long)orow * LDO + d0 * 32 + r32] = __float2bfloat16(o[d0][r] * rli[r]); }
#undef SLOAD
#undef SWRITE
#undef SWAIT
  __syncthreads();
}

__device__ __forceinline__ void attn_b_unit(const bf16* __restrict__ P, bf16* __restrict__ OBG, float* __restrict__ LSE, const float* btab, char* vlds, float* ws, int unit, int lane) {
  using St = Stage<bf16>;
  const int r32 = lane & 31, hi = lane >> 5;
  const int g = unit >> 10, rest = unit & 1023, b = rest >> 8, h = (rest >> 6) & 3, idx = rest & 63;
  const int dsh = 2 * g, d = 1 << dsh, rd = idx & (d - 1), qblk = idx >> dsh;
  const int kq = 32 * qblk + r32;
  const int tq = rd + (kq << dsh);
  float* li_l = ws; float* al_l = ws + 32;
  float m_reg = -1e30f, l_reg = 0; f32x16 o[4] = {};
  const int vb0 = (int)(uintptr_t)vlds + v_rd_base(lane);
  const int srow = lane >> 4, sc = (lane & 15) * 8;
  const bf16* Qp = P + (size_t)(b * SEQ + tq) * INW + C_QB + g * 512 + h * 128 + hi * 8;
  bf16x8 qr[8];
#pragma unroll
  for (int d0 = 0; d0 < 8; ++d0) qr[d0] = St::ld8(Qp + d0 * 16);
  const int L64 = (SEQ >> dsh) >> 6;
  int tlo = (32 * qblk - 64) >> 6, thi = (32 * qblk + 31 + 64) >> 6; tlo = tlo < 0 ? 0 : tlo; thi = thi > L64 - 1 ? L64 - 1 : thi;
  const size_t rstride = (size_t)d * INW;
  const bf16* Kb = P + (size_t)(b * SEQ + rd) * INW + C_KB + g * 512 + h * 128;
  const bf16* Vb = Kb + (C_VB - C_KB);
  const float* bt = btab + (g * 4 + h) * 129 + 64;
  for (int t = tlo; t <= thi; ++t) {
    const int k0 = t * 64;
    f32x16 p0 = {}, p1 = {};
    { const bf16* K0 = Kb + (size_t)(k0 + r32) * rstride + hi * 8; const bf16* K1 = K0 + 32 * rstride;
#pragma unroll
      for (int d0 = 0; d0 < 8; ++d0) { const bf16x8 b0 = St::ld8(K0 + d0 * 16), b1 = St::ld8(K1 + d0 * 16);
        p0 = __builtin_amdgcn_mfma_f32_32x32x16_bf16(b0, qr[d0], p0, 0, 0, 0);
        p1 = __builtin_amdgcn_mfma_f32_32x32x16_bf16(b1, qr[d0], p1, 0, 0, 0); } }
    { const bf16* V0 = Vb + (size_t)(k0 + srow) * rstride + sc;
#pragma unroll
      for (int it = 0; it < 16; ++it) { const bf16x8 v = St::ld8(V0 + (size_t)(4 * it) * rstride); *(bf16x8*)(vlds + v_st(4 * it + srow, sc)) = v; } }
#pragma unroll
    for (int r = 0; r < 16; ++r) { const int rel = k0 + crow(r, hi) - kq; const int rc = rel < -64 ? -64 : (rel > 64 ? 64 : rel);
      p0[r] = (rel == rc) ? p0[r] + bt[rc] : -1e30f; }
#pragma unroll
    for (int r = 0; r < 16; ++r) { const int rel = k0 + 32 + crow(r, hi) - kq; const int rc = rel < -64 ? -64 : (rel > 64 ? 64 : rel);
      p1[r] = (rel == rc) ? p1[r] + bt[rc] : -1e30f; }
    float mn, alpha; bf16x8 pa0, pa1, pa2, pa3;
    partialSM(p0, p1, m_reg, mn, alpha);
    RESC(alpha);
    finishSM(p0, p1, alpha, l_reg, pa0, pa1, pa2, pa3);
    asm volatile("s_waitcnt lgkmcnt(0)" ::: "memory"); SBAR();
    pv_d0(o, vb0, pa0, pa1, pa2, pa3);
  }
  if (hi == 0) { li_l[r32] = l_reg; LSE[((size_t)g * TOK + b * SEQ + tq) * 4 + h] = m_reg * SCALE + __logf(l_reg); }
  asm volatile("s_waitcnt lgkmcnt(0)" ::: "memory");
  float rli[16];
#pragma unroll
  for (int r = 0; r < 16; ++r) rli[r] = __builtin_amdgcn_rcpf(li_l[crow(r, hi)]);
#pragma unroll
  for (int r = 0; r < 16; ++r) { const int i = crow(r, hi); bf16* Ow = OBG + ((size_t)g * TOK + b * SEQ + rd + ((32 * qblk + i) << dsh)) * 512 + h * 128 + r32;
    for (int d0 = 0; d0 < 4; ++d0) Ow[d0 * 32] = __float2bfloat16(o[d0][r] * rli[r]); }
  asm volatile("s_waitcnt lgkmcnt(0)" ::: "memory");
}
#undef RESC
}
#define LAS __attribute__((address_space(3)))
typedef unsigned short bf16r;
typedef unsigned v4u __attribute__((ext_vector_type(4)));
typedef float v4f __attribute__((ext_vector_type(4)));
constexpr int NWAVES = 8, NTHREADS = 512;
constexpr int LDS_BYTES = 147456, RING_BYTES = 131072;
constexpr size_t MiB = 1u << 20;
constexpr size_t WS_SUMSQ = 0;
constexpr size_t WS_BTAB = 64 * 1024;
constexpr size_t WS_CTRS = 96 * 1024;
constexpr size_t WS_NORMW = 112 * 1024;
constexpr size_t WS_XBAR = 256 * 1024;
constexpr size_t WS_ROPE = 128 * 1024;
constexpr size_t WS_WIN = 1 * MiB;
constexpr size_t WS_WPA = WS_WIN + (size_t)INW * DM * 2;
constexpr size_t WS_WOUT = WS_WPA + (size_t)DM * 2560 * 2;
constexpr size_t WS_WGU = WS_WOUT + (size_t)DM * DM * 2;
constexpr size_t WS_WDN = WS_WGU + (size_t)NGU * DM * 2;
constexpr size_t WS_XN = WS_WDN + (size_t)DM * DFF * 2;
constexpr size_t WS_OA = WS_XN + (size_t)TOK * DM * 2;
constexpr size_t WS_OB = WS_OA + (size_t)TOK * 2560 * 2;
constexpr size_t WS_MG = WS_OB + (size_t)TOK * 512 * 2;
constexpr size_t WS_P = WS_MG + (size_t)TOK * DM * 2;
constexpr size_t WS_OBG = WS_P + (size_t)TOK * INW * 2;
constexpr size_t WS_LSE = WS_OBG + (size_t)3 * TOK * 512 * 2;
constexpr size_t WS_KVA = WS_LSE + (size_t)3 * TOK * 4 * 4;
constexpr size_t WS_END = WS_KVA + (size_t)BATCH * 8 * SEQ * 128 * 2;

__device__ __forceinline__ unsigned f2bf(float f) { unsigned u = __builtin_bit_cast(unsigned, f); return (u + 0x7fffu + ((u >> 16) & 1u)) >> 16; }
__device__ __forceinline__ unsigned pk2(float lo, float hi) { return f2bf(lo) | (f2bf(hi) << 16); }
__device__ __forceinline__ float wave_sum(float v) {
#pragma unroll
    for (int o = 1; o < 64; o <<= 1) v += __shfl_xor(v, o);
    return v;
}
struct CvtItem { const float* src; bf16r* dst; const float* kscale; int N, K, k0, n0, drow0, perm; };
__device__ __forceinline__ void cvt_load(const CvtItem& c, v4f (&r)[16], int lane) {
    const int lr = lane >> 4, lc = (lane & 15) * 4; const float* p = c.src + (size_t)(c.k0 + lr) * c.N + c.n0 + lc;
#pragma unroll
    for (int i = 0; i < 16; ++i) r[i] = *(const v4f*)(p + (size_t)(4 * i) * c.N);
}
__device__ __forceinline__ void cvt_process(const CvtItem& c, v4f (&r)[16], LAS float* scr, int lane) {
    const int lr = lane >> 4, lc = (lane & 15) * 4;
#pragma unroll
    for (int i = 0; i < 16; ++i) { const int kk = 4 * i + lr; v4f v = r[i];
        if (c.kscale) { const float sc = c.kscale[c.k0 + kk]; v = v * sc; }
        LAS float* d = scr + kk * 65 + lc; d[0] = v[0]; d[1] = v[1]; d[2] = v[2]; d[3] = v[3]; }
    asm volatile("s_waitcnt lgkmcnt(0)" ::: "memory");
    const int cc = lane & 7;
#pragma unroll
    for (int j = 0; j < 8; ++j) { const int n = (lane >> 3) + 8 * j; const LAS float* sp = scr + (8 * cc) * 65 + n;
        v4u o; o.x = pg8::cvt_pk_bf16(sp[0 * 65], sp[1 * 65]); o.y = pg8::cvt_pk_bf16(sp[2 * 65], sp[3 * 65]); o.z = pg8::cvt_pk_bf16(sp[4 * 65], sp[5 * 65]); o.w = pg8::cvt_pk_bf16(sp[6 * 65], sp[7 * 65]);
        const int nd = c.perm ? (((n & 31) >> 2) * 8 + (n >> 5) * 4 + (n & 3)) : n;
        *(v4u*)(c.dst + (size_t)(c.drow0 + nd) * c.K + c.k0 + 8 * cc) = o; }
    asm volatile("s_waitcnt lgkmcnt(0)" ::: "memory");
}
template <class Decode, class Next>
__device__ __forceinline__ void cvt_run(const Decode& dec, Next& next, LAS float* scr, int lane) {
    v4f ra[16], rb[16]; CvtItem ia, ib;
    int ida = next(); if (ida < 0) return;
    ia = dec(ida); cvt_load(ia, ra, lane);
    for (;;) {
        const int idb = next(); if (idb >= 0) { ib = dec(idb); cvt_load(ib, rb, lane); }
        cvt_process(ia, ra, scr, lane);
        if (idb < 0) break;
        ida = next(); if (ida >= 0) { ia = dec(ida); cvt_load(ia, ra, lane); }
        cvt_process(ib, rb, scr, lane);
        if (ida < 0) break;
    }
}
struct NextStatic { int cur, step, total; __device__ __forceinline__ int operator()() { const int v = cur; cur += step; return v < total ? v : -1; } };
struct NextQueue { unsigned* ctr; int total, lane; int cur = 0, end = 0; static constexpr int CH = 8;
    __device__ __forceinline__ int operator()() { if (cur >= end) { unsigned v = 0; if (lane == 0) v = atomicAdd(ctr, (unsigned)CH); v = __builtin_amdgcn_readfirstlane(v); if (v >= (unsigned)total) return -1; cur = (int)v; end = cur + CH < total ? cur + CH : total; } return cur++; } };

#define XB_TMO      128
#define XB_XCNT(j)  (256  + 64 * (j))
#define XB_XSUB(j)  (1280 + 64 * (j))
#define XB_XGEN(j)  (2304 + 64 * (j))
#define XB_TOP      3328
#define XB_TOPGEN   3392
#define XCD_BAR_WORDS 3456
#define XB_SPIN_CAP (1u << 18)

__device__ __forceinline__ unsigned xb_ld(unsigned* p)              { return __hip_atomic_load(p, __ATOMIC_RELAXED, __HIP_MEMORY_SCOPE_AGENT); }
__device__ __forceinline__ unsigned xb_add(unsigned* p, unsigned v) { return __hip_atomic_fetch_add(p, v, __ATOMIC_RELAXED, __HIP_MEMORY_SCOPE_AGENT); }
__device__ __forceinline__ unsigned xb_xcc_id() { return (unsigned)__builtin_amdgcn_s_getreg((3 << 11) | 20) & 0xFu; }
#define XB_SPIN(cond, bar) do { unsigned _sp = 0; while (cond) { __builtin_amdgcn_s_sleep(1); \
    if ((++_sp & 255u) == 0u) { if (xb_ld(&(bar)[XB_TMO])) break; if (_sp > XB_SPIN_CAP) { atomicAdd(&(bar)[XB_TMO], 1u); break; } } } } while (0)

struct XcdBarrier {
    unsigned* bar; unsigned x;
    volatile LAS unsigned* st;
};

__device__ __forceinline__ XcdBarrier xcd_barrier_post(unsigned* bar, volatile LAS unsigned* st) {
    XcdBarrier b; b.bar = bar; b.x = xb_xcc_id(); b.st = st;
    if (threadIdx.x == 0) (void)xb_add(&bar[XB_XCNT(b.x)], 1u);
    return b;
}
__device__ __forceinline__ void xcd_barrier_complete(unsigned* bar, unsigned x, unsigned& nloc, unsigned& nx) {
    const unsigned G = gridDim.x * gridDim.y * gridDim.z;
    unsigned sum, cnt, mine, sp = 0u;
    for (;;) {
        sum = 0u; cnt = 0u; mine = 0u;
#pragma unroll
        for (unsigned j = 0; j < 16; ++j) { const unsigned c = xb_ld(&bar[XB_XCNT(j)]); sum += c; cnt += (c > 0u) ? 1u : 0u; mine = (j == x) ? c : mine; }
        if (sum == G) break;
        __builtin_amdgcn_s_sleep(1);
        if ((++sp & 255u) == 0u) { if (xb_ld(&bar[XB_TMO])) break; if (sp > XB_SPIN_CAP) { atomicAdd(&bar[XB_TMO], 1u); break; } }
    }
    nloc = mine > 0u ? mine : 1u; nx = cnt > 0u ? cnt : 1u;
}

__device__ __forceinline__ void xcd_barrier(const XcdBarrier& b) {
    asm volatile("s_waitcnt vmcnt(0)" ::: "memory");
    __syncthreads();
    if (threadIdx.x == 0) {
        unsigned* bar = b.bar;
        __builtin_amdgcn_s_waitcnt(0);
        unsigned nloc = b.st[0], nx = b.st[1];
        if (nloc == 0u) { xcd_barrier_complete(bar, b.x, nloc, nx); b.st[0] = nloc; b.st[1] = nx; }
        const unsigned old = xb_add(&bar[XB_XSUB(b.x)], 1u);
        const unsigned gen = old / nloc;
        if (old + 1u == (gen + 1u) * nloc) {
            __builtin_amdgcn_fence(__ATOMIC_RELEASE, "agent");
            asm volatile("s_waitcnt vmcnt(0)" ::: "memory");
            const unsigned og = xb_add(&bar[XB_TOP], 1u);
            const unsigned tg = og / nx;
            if (og + 1u == (tg + 1u) * nx) xb_add(&bar[XB_TOPGEN], 1u);
            else XB_SPIN(xb_ld(&bar[XB_TOPGEN]) == tg, bar);
            __builtin_amdgcn_fence(__ATOMIC_ACQUIRE, "agent");
            xb_add(&bar[XB_XGEN(b.x)], 1u);
            asm volatile("s_waitcnt vmcnt(0)" ::: "memory");
        } else {
            XB_SPIN(xb_ld(&bar[XB_XGEN(b.x)]) == gen, bar);
            __builtin_amdgcn_fence(__ATOMIC_ACQUIRE, "agent");
            asm volatile("s_waitcnt vmcnt(0)" ::: "memory");
        }
    }
    __syncthreads();
}


struct DecPlain { const float* w; bf16r* d; int N, K, perm_below;
    __device__ __forceinline__ CvtItem operator()(int r) const { CvtItem c; const int nb = N / 64, kb = r / nb, n0 = (r % nb) * 64; c.src = w; c.dst = d; c.kscale = nullptr; c.N = N; c.K = K; c.k0 = kb * 64; c.n0 = n0; c.drow0 = n0; c.perm = n0 < perm_below; return c; } };
struct DecGU { const float *wg, *wu, *n2; bf16r* d;
    static constexpr int I_G = 64 * (DFF / 64);
    __device__ __forceinline__ CvtItem operator()(int r) const { CvtItem c; const int which = r >= I_G; if (which) r -= I_G; const int nb = DFF / 64, kb = r / nb, n0 = (r % nb) * 64;
        c.src = which ? wu : wg; c.dst = d; c.kscale = n2; c.N = DFF; c.K = DM; c.k0 = kb * 64; c.n0 = n0; c.drow0 = (n0 >> 7) * 256 + which * 128 + (n0 & 127); c.perm = 0; return c; } };

struct Args { const float* in[16]; float* out; unsigned char* ws; };

__global__ void __launch_bounds__(NTHREADS) fwd_megakernel(Args a) {
    extern __shared__ __attribute__((aligned(16))) unsigned char lds[];
    cg::grid_group grid = cg::this_grid();
#define PH_BEGIN() unsigned char* wsl = a.ws; asm volatile("" : "+s"(wsl)); const int wave = wave_s; int lane; asm volatile("v_mbcnt_lo_u32_b32 %0, -1, 0\n\tv_mbcnt_hi_u32_b32 %0, -1, %0" : "=v"(lane)); const int tid = wave * 64 + lane; \
    const int G = gridDim.x, gw = blockIdx.x * NWAVES + wave, NGW = G * NWAVES; \
    (void)lane; (void)gw; (void)NGW; (void)wsl
#define A_x        (a.in[0])
#define A_norm1_g  (a.in[1])
#define A_w_in     (a.in[2])
#define A_b_gate   (a.in[3])
#define A_q_norm_a (a.in[4])
#define A_k_norm_a (a.in[5])
#define A_q_norm_b (a.in[6])
#define A_k_norm_b (a.in[7])
#define A_rel_bias (a.in[8])
#define A_w_pa     (a.in[9])
#define A_w_pb     (a.in[10])
#define A_w_out    (a.in[11])
#define A_norm2_g  (a.in[12])
#define A_w_gate   (a.in[13])
#define A_w_up     (a.in[14])
#define A_w_down   (a.in[15])
#define A_out      (a.out)
#define SUMSQ ((float*)(wsl + WS_SUMSQ))
#define BTAB  ((float*)(wsl + WS_BTAB))
#define CTRS  ((unsigned*)(wsl + WS_CTRS))
#define XBAR  ((unsigned*)(wsl + WS_XBAR))
#define NORMW ((float*)(wsl + WS_NORMW))
#define ROPE  ((float*)(wsl + WS_ROPE))
#define WIN   ((bf16r*)(wsl + WS_WIN))
#define WPA   ((bf16r*)(wsl + WS_WPA))
#define WPB   ((bf16r*)(wsl + WS_WPA) + 2048)
#define WOUT  ((bf16r*)(wsl + WS_WOUT))
#define WGU   ((bf16r*)(wsl + WS_WGU))
#define WDN   ((bf16r*)(wsl + WS_WDN))
#define XN    ((bf16r*)(wsl + WS_XN))
#define OA    ((bf16r*)(wsl + WS_OA))
#define OB    ((bf16r*)(wsl + WS_OB))
#define MG    ((bf16r*)(wsl + WS_MG))
#define OBG   ((bf16r*)(wsl + WS_OBG))
#define LSE   ((float*)(wsl + WS_LSE))
#define KVA   ((bf16r*)(wsl + WS_KVA))
#define A_P     ((bf16r*)(wsl + WS_P))
#define ACT   ((bf16r*)(wsl + WS_P))
    PG8_LAS unsigned char* ring = (PG8_LAS unsigned char*)lds;
    const int wave_s = __builtin_amdgcn_readfirstlane(threadIdx.x >> 6);

    { PH_BEGIN();
        const int gt = blockIdx.x * NTHREADS + tid, NGT = G * NTHREADS;
        for (int i = gt; i < TOK; i += NGT) SUMSQ[i] = 0.f;
        for (int i = gt; i < 3456; i += NGT) XBAR[i] = 0u;
        if (tid < 4) ((LAS unsigned*)(lds + LDS_BYTES - 16))[tid] = 0u;
        for (int i = gt; i < 12 * 129; i += NGT) {
            const int hh = i / 129, jj = i % 129, g = hh >> 2, d = 1 << (2 * g), rel = (jj - 64) * d;
            const int n = rel < 0 ? -rel : rel; const int side = rel > 0 ? 16 : 0;
            const float nf = (float)(n < 1 ? 1 : n);
            int large = 8 + (int)(logf(nf / 8.f) / 4.852030263919617f * 8.f); large = large > 15 ? 15 : large;
            const int bucket = side + (n < 8 ? n : large);
            BTAB[i] = A_rel_bias[bucket * 12 + hh] * (1.0f / att::SCALE);
        }
        for (int i = gt; i < 64 * 32; i += NGT) {
            const int pos = i >> 5, j = i & 31; const float inv = powf(10000.f, -(float)(2 * j) / 64.f); const float ang = (float)pos * inv;
            ROPE[2 * i] = cosf(ang); ROPE[2 * i + 1] = sinf(ang);
        }
        if (gt < 128) { CTRS[gt] = 0u; NORMW[gt] = A_q_norm_a[gt]; NORMW[128 + gt] = A_k_norm_a[gt]; NORMW[256 + gt] = A_q_norm_b[gt]; NORMW[384 + gt] = A_k_norm_b[gt]; }
        LAS float* scr = (LAS float*)(lds) + wave * (64 * 65);
        { DecPlain dec{A_w_in, WIN, INW, DM, C_VA}; NextStatic nx{gw, NGW, 64 * (INW / 64)}; cvt_run(dec, nx, scr, lane); }

        for (int m = gw; m < TOK; m += NGW) {
            const v4f* xr = (const v4f*)(A_x + (size_t)m * DM) + lane; v4f v[16]; float s = 0.f;
#pragma unroll
            for (int j = 0; j < 16; ++j) { v[j] = xr[64 * j]; s += (v[j][0] * v[j][0] + v[j][1] * v[j][1]) + (v[j][2] * v[j][2] + v[j][3] * v[j][3]); }
            const float rstd = 1.0f / sqrtf(wave_sum(s) * (1.0f / DM) + EPS);
            unsigned long long* o8 = (unsigned long long*)(XN + (size_t)m * DM) + lane;
#pragma unroll
            for (int j = 0; j < 16; ++j) { const v4f g = ((const v4f*)A_norm1_g)[lane + 64 * j];
                o8[64 * j] = (unsigned long long)pk2(v[j][0] * rstd * g[0], v[j][1] * rstd * g[1]) | ((unsigned long long)pk2(v[j][2] * rstd * g[2], v[j][3] * rstd * g[3]) << 32); }
        }
    }
    grid.sync();
    const XcdBarrier xbar = xcd_barrier_post((unsigned*)(a.ws + WS_XBAR), (volatile LAS unsigned*)(lds + LDS_BYTES - 16));

    { PH_BEGIN();
        const int NG1 = G;
        if ((int)blockIdx.x < NG1) {
            pg8::Gemm g{XN, WIN, TOK, INW, DM}; pg8::StaticOrder S; S.init(TOK, INW, NG1, (int)blockIdx.x);
            pg8::EpiIn E{A_P, KVA, A_b_gate, NORMW, ROPE, (PG8_LAS float*)(ring + RING_BYTES)};
            pg8::gemm_phase<pg8::EpiIn, pg8::StaticOrder, true, true>(ring, g, S, E, tid);
        }
        { LAS float* scr = (LAS float*)(lds) + wave * (64 * 65);
          { DecPlain dec{A_w_out, WOUT, DM, DM, 0}; NextQueue nx{CTRS + 16, 64 * 64, lane}; cvt_run(dec, nx, scr, lane); }
          { DecPlain dec{A_w_pa, WPA, DM, 2560, 0}; NextQueue nx{CTRS + 32, 32 * 64, lane}; cvt_run(dec, nx, scr, lane); }
          { DecPlain dec{A_w_pb, WPB, DM, 2560, 0}; NextQueue nx{CTRS + 48, 8 * 64, lane}; cvt_run(dec, nx, scr, lane); }
          { DecGU dec{A_w_gate, A_w_up, A_norm2_g, WGU}; NextQueue nx{CTRS + 0, 2 * DecGU::I_G, lane}; cvt_run(dec, nx, scr, lane); } }
    }
    xcd_barrier(xbar);

    { PH_BEGIN();
        for (int u = blockIdx.x; u < BATCH * 16 * 8; u += G) {
            const int qb = u & 7, h = (u >> 3) & 15, b = u >> 7, kvh = h >> 2;
            const att::bf16* Pb = (const att::bf16*)A_P + (size_t)(b * SEQ) * INW;
            const att::bf16* Kc = (const att::bf16*)KVA + ((size_t)(b * 8 + kvh) * SEQ) * 128; const att::bf16* Vc = Kc + (size_t)4 * SEQ * 128;
            att::attn_dense_body<INW, 128, 2560>(Pb + (size_t)(qb * 256) * INW + C_QA + h * 128, Kc, Vc,
                                                 (att::bf16*)OA + (size_t)(b * SEQ + qb * 256) * 2560 + h * 128, SEQ, (char*)lds, tid);
        }
        float* btab = (float*)(lds + RING_BYTES + 2048);
        for (int i = tid; i < 12 * 129; i += NTHREADS) btab[i] = BTAB[i];
        __syncthreads();
        if (NGW == 2048) {
            att::attn_b_unit((const att::bf16*)A_P, (att::bf16*)OBG, LSE, btab, (char*)lds + wave * 16384, (float*)(lds + RING_BYTES) + wave * 64, (gw >> 1) + 1024 * (gw & 1), lane);
            if (!(gw & 1)) att::attn_b_unit((const att::bf16*)A_P, (att::bf16*)OBG, LSE, btab, (char*)lds + wave * 16384, (float*)(lds + RING_BYTES) + wave * 64, 2048 + (gw >> 1), lane);
        } else
        for (int u = gw; u < 3072; u += NGW)
            att::attn_b_unit((const att::bf16*)A_P, (att::bf16*)OBG, LSE, btab, (char*)lds + wave * 16384, (float*)(lds + RING_BYTES) + wave * 64, u, lane);
    }
    xcd_barrier(xbar);

    { PH_BEGIN();
        pg8::StaticOrder S; S.init(TOK, DM, G, (int)blockIdx.x);
        {
            int done_pm = -1;
            for (int ui = 0; ; ++ui) { pg8::Unit uu; if (!S.next(ui, uu)) break; if (uu.pm == done_pm) continue; done_pm = uu.pm;
                const int ch = tid & 63, hh = ch >> 4;
                for (int it0 = 0; it0 < 32; it0 += 8) {
                    float l[8][3]; v4u av[8][3];
#pragma unroll
                    for (int j = 0; j < 8; ++j) { const int row = uu.pm * 256 + (it0 + j) * 8 + (tid >> 6);
#pragma unroll
                        for (int g = 0; g < 3; ++g) { l[j][g] = LSE[((size_t)g * TOK + row) * 4 + hh]; av[j][g] = *(const v4u*)(OBG + ((size_t)g * TOK + row) * 512 + ch * 8); } }
#pragma unroll
                    for (int j = 0; j < 8; ++j) { const int row = uu.pm * 256 + (it0 + j) * 8 + (tid >> 6);
                        const float mx = fmaxf(l[j][0], fmaxf(l[j][1], l[j][2])); float w0 = __expf(l[j][0] - mx), w1 = __expf(l[j][1] - mx), w2 = __expf(l[j][2] - mx); const float inv = 1.0f / (w0 + w1 + w2); w0 *= inv; w1 *= inv; w2 *= inv;
                        pg8::f32x4 x0, x1, y0, y1, z0, z1; pg8::unpack8(av[j][0], x0, x1); pg8::unpack8(av[j][1], y0, y1); pg8::unpack8(av[j][2], z0, z1);
                        *(v4u*)(OA + (size_t)row * 2560 + 2048 + ch * 8) = pg8::pack8(x0 * w0 + y0 * w1 + z0 * w2, x1 * w0 + y1 * w1 + z1 * w2); } } }
            asm volatile("s_waitcnt vmcnt(0)" ::: "memory"); __syncthreads();
        }
        { pg8::Gemm g{OA, WPA, TOK, DM, 2560}; pg8::EpiMerge E{A_P, MG, 32}; pg8::gemm_phase<pg8::EpiMerge, pg8::StaticOrder, true, true>(ring, g, S, E, tid); }
    }
    xcd_barrier(xbar);

    { PH_BEGIN();
        pg8::Gemm g{MG, WOUT, TOK, DM, DM}; pg8::StaticOrder S; S.init(TOK, DM, G, (int)blockIdx.x);
        pg8::EpiOut E{A_x, A_out, XN, SUMSQ};
        pg8::gemm_phase<pg8::EpiOut, pg8::StaticOrder, true, true>(ring, g, S, E, tid);
    }
    xcd_barrier(xbar);

    { PH_BEGIN();
        const int NG6 = G;
        if ((int)blockIdx.x < NG6) {
            pg8::Gemm g{XN, WGU, TOK, NGU, DM}; pg8::StaticOrder S; S.init(TOK, NGU, NG6, (int)blockIdx.x);
            pg8::EpiGU E{SUMSQ, ACT};
            pg8::gemm_phase<pg8::EpiGU, pg8::StaticOrder, true, true>(ring, g, S, E, tid);
        }
        { LAS float* scr = (LAS float*)(lds) + wave * (64 * 65);
          { DecPlain dec{A_w_down, WDN, DM, DFF, 0}; NextQueue nx{CTRS + 64, (DFF / 64) * 64, lane}; cvt_run(dec, nx, scr, lane); } }

    }
    xcd_barrier(xbar);

    { PH_BEGIN();
        pg8::Gemm g{ACT, WDN, TOK, DM, DFF}; pg8::StaticOrder S; S.init(TOK, DM, G, (int)blockIdx.x);
        pg8::EpiDown E{XN, A_out};
        pg8::gemm_phase<pg8::EpiDown, pg8::StaticOrder, true, true>(ring, g, S, E, tid);
    }
}

extern "C" void kernel_launch(void* const* d_in, const int* in_sizes, int n_in, void* d_out, int out_size, void* d_ws, size_t ws_size, hipStream_t stream) {
    static int grid_blocks = 0;
    if (grid_blocks == 0) {
        if (n_in != 16 || in_sizes[0] != TOK * DM || out_size != TOK * DM || ws_size < WS_END) {
            fprintf(stderr, "kernel_launch: unexpected shapes (n_in %d, in0 %d, out %d, ws %zu, need %zu); nothing launched\n", n_in, n_in > 0 ? in_sizes[0] : -1, out_size, ws_size, (size_t)WS_END); grid_blocks = -1; return; }
        int dev = 0, cus = 0, per_cu = 0;
        hipGetDevice(&dev); hipDeviceGetAttribute(&cus, hipDeviceAttributeMultiprocessorCount, dev);
        if (hipFuncSetAttribute((const void*)fwd_megakernel, hipFuncAttributeMaxDynamicSharedMemorySize, LDS_BYTES) != hipSuccess) { fprintf(stderr, "kernel_launch: hipFuncSetAttribute failed\n"); grid_blocks = -1; return; }
        if (hipOccupancyMaxActiveBlocksPerMultiprocessor(&per_cu, (const void*)fwd_megakernel, NTHREADS, LDS_BYTES) != hipSuccess || per_cu < 1) { fprintf(stderr, "kernel_launch: occupancy query gave %d\n", per_cu); per_cu = 1; (void)hipGetLastError(); }
        grid_blocks = cus * per_cu;
    }
    if (grid_blocks < 0) return;
    Args a{};
    for (int i = 0; i < 16; ++i) a.in[i] = (const float*)d_in[i];
    a.out = (float*)d_out; a.ws = (unsigned char*)d_ws;
    void* args[] = {&a};
    hipError_t e = hipLaunchCooperativeKernel((const void*)fwd_megakernel, dim3(grid_blocks), dim3(NTHREADS), args, LDS_BYTES, stream);
    if (e != hipSuccess) fprintf(stderr, "cooperative launch failed: %s (grid %d)\n", hipGetErrorString(e), grid_blocks);
}
```
